# Optimizing an MI355X kernel written in HIP

```python
import math
import jax, jax.numpy as jnp
from jax import lax
import numpy as np

D_MODEL = 1024
BATCH = 2
SEQ = 8192
DEPTH = 1

N_MEM = 256
D_MIX = D_MODEL
D_RNN = D_MIX // 2
RNN_HEADS = 8
RNN_HEAD_DIM = D_RNN // RNN_HEADS
CONV_WIDTH = 4
LRU_C = 8.0
D_POOL = D_MIX // 4
POOL_WINDOWS = (2, 4, 8, 16)
POOL_GROUPS = len(POOL_WINDOWS)
POOL_GROUP_DIM = D_POOL // POOL_GROUPS
MAX_WINDOW = max(POOL_WINDOWS)
D_XATTN = D_MIX // 4
XATTN_HEADS = 4
XATTN_HEAD_DIM = D_XATTN // XATTN_HEADS
D_IN = 2 * D_RNN + D_POOL + D_XATTN
N_EXPERTS = 32
TOP_K = 4
D_FF = D_MODEL
SWIGLU_ALPHA = 1.702
SWIGLU_LIMIT = 7.0
MOE_BLOCK = 128
RMS_EPS = 1e-6

kernel_name = "hymba_rglru_pool_memxattn_moe"


def rmsnorm(x, g):
    xf = x.astype(jnp.float32)
    y = xf * lax.rsqrt(jnp.mean(xf * xf, axis=-1, keepdims=True) + RMS_EPS)
    return (y * g.astype(jnp.float32)).astype(x.dtype)


def causal_depthwise_conv(u, w, b):
    y = lax.conv_general_dilated(
        u, w[:, None, :].astype(u.dtype), window_strides=(1,),
        padding=[(CONV_WIDTH - 1, 0)],
        dimension_numbers=("NWC", "WIO", "NWC"),
        feature_group_count=u.shape[-1])
    return y + b.astype(u.dtype)


def rg_lru(u, w_a, b_a, w_i, b_i, lam):
    B, S, C = u.shape
    uh = u.reshape(B, S, RNN_HEADS, RNN_HEAD_DIM)
    r = jax.nn.sigmoid(jnp.einsum("bshi,hij->bshj", uh, w_a).reshape(B, S, C) + b_a)
    i = jax.nn.sigmoid(jnp.einsum("bshi,hij->bshj", uh, w_i).reshape(B, S, C) + b_i)
    log_a = -LRU_C * r.astype(jnp.float32) * jax.nn.softplus(-lam.astype(jnp.float32))
    a = jnp.exp(log_a)
    mult = jnp.sqrt(jnp.maximum(-jnp.expm1(2.0 * log_a), 0.0))
    is_start = (jnp.arange(S) == 0)[None, :, None]
    mult = jnp.where(is_start, 1.0, mult)
    bx = mult * (i * u).astype(jnp.float32)

    def combine(left, right):
        a1, b1 = left
        a2, b2 = right
        return a1 * a2, a2 * b1 + b2

    _, h = lax.associative_scan(combine, (a, bx), axis=1)
    return h.astype(u.dtype)


def multiscale_pool(u, w_pool, scale):
    B, S, _ = u.shape
    uf = u.astype(jnp.float32).reshape(B, S, POOL_GROUPS, POOL_GROUP_DIM)
    csum = jnp.cumsum(uf, axis=1)
    cpad = jnp.pad(csum, ((0, 0), (MAX_WINDOW, 0), (0, 0), (0, 0)))
    pos = jnp.arange(1, S + 1, dtype=jnp.float32)[None, :, None]
    outs = []
    for g, w in enumerate(POOL_WINDOWS):
        prev = cpad[:, MAX_WINDOW - w: MAX_WINDOW - w + S, g]
        mean = (csum[:, :, g] - prev) / jnp.minimum(pos, float(w))
        outs.append(mean - uf[:, :, g])
    d = jnp.stack(outs, axis=2).astype(u.dtype)
    y = jnp.einsum("bsgi,gij->bsgj", d, w_pool).reshape(B, S, D_POOL)
    return y * scale


def memory_cross_attention(q, mem_n, w_mem_kv):
    B, S, _ = q.shape
    kv = mem_n @ w_mem_kv
    k, v = jnp.split(kv, 2, axis=-1)
    qh = q.reshape(B, S, XATTN_HEADS, XATTN_HEAD_DIM)
    kh = k.reshape(B, -1, XATTN_HEADS, XATTN_HEAD_DIM)
    vh = v.reshape(B, -1, XATTN_HEADS, XATTN_HEAD_DIM)
    s = jnp.einsum("bshd,bmhd->bhsm", qh, kh).astype(jnp.float32) * (XATTN_HEAD_DIM ** -0.5)
    p = jax.nn.softmax(s, axis=-1).astype(vh.dtype)
    o = jnp.einsum("bhsm,bmhd->bshd", p, vh)
    return o.reshape(B, S, D_XATTN)


def moe_ffn(x, w_router, b_router, w_gu, b_gu, w_down, b_down):
    B, S, D = x.shape
    T = B * S
    TK = T * TOP_K
    xt = x.reshape(T, D)
    logits = (xt @ w_router + b_router).astype(jnp.float32)
    top_vals, top_idx = lax.top_k(logits, TOP_K)
    gates = jax.nn.softmax(top_vals, axis=-1)
    flat_e = top_idx.reshape(-1).astype(jnp.int32)
    flat_tok = jnp.arange(TK, dtype=jnp.int32) // TOP_K
    order = jnp.argsort(flat_e, stable=True)
    sorted_e = flat_e[order]
    sorted_tok = flat_tok[order]
    sorted_gate = gates.reshape(-1)[order]
    counts = jnp.bincount(flat_e, length=N_EXPERTS)
    padded = ((counts + MOE_BLOCK - 1) // MOE_BLOCK) * MOE_BLOCK
    pad_end = jnp.cumsum(padded)
    pad_start = pad_end - padded
    start = jnp.cumsum(counts) - counts
    dest = pad_start[sorted_e] + (jnp.arange(TK, dtype=jnp.int32) - start[sorted_e])
    n_blocks = (TK + N_EXPERTS * (MOE_BLOCK - 1) + MOE_BLOCK - 1) // MOE_BLOCK
    n_pad = n_blocks * MOE_BLOCK
    buf_tok = jnp.full((n_pad,), T, jnp.int32).at[dest].set(sorted_tok)
    buf_gate = jnp.zeros((n_pad,), jnp.float32).at[dest].set(sorted_gate)
    block_start = jnp.arange(n_blocks, dtype=jnp.int32) * MOE_BLOCK
    block_e = jnp.minimum(jnp.searchsorted(pad_end, block_start, side="right"), N_EXPERTS - 1)
    xpad = jnp.concatenate([xt, jnp.zeros((1, D), xt.dtype)], axis=0)

    def expert_block(args):
        e, tok = args
        xb = xpad[tok]
        gu = xb @ w_gu[e] + b_gu[e]
        g, up = jnp.split(gu, 2, axis=-1)
        g = jnp.minimum(g, SWIGLU_LIMIT)
        up = jnp.clip(up, -SWIGLU_LIMIT, SWIGLU_LIMIT)
        glu = g * jax.nn.sigmoid(g * SWIGLU_ALPHA)
        return ((up + 1.0) * glu) @ w_down[e] + b_down[e]

    yb = lax.map(expert_block, (block_e, buf_tok.reshape(n_blocks, MOE_BLOCK)))
    y = yb.reshape(n_pad, D) * buf_gate[:, None].astype(yb.dtype)
    out = jnp.zeros((T + 1, D), yb.dtype).at[buf_tok].add(y)[:T]
    return out.reshape(B, S, D)


def setup_inputs(seed: int = 0) -> dict:
    key = jax.random.key(seed)
    ks = jax.random.split(key, 24)
    f32 = jnp.float32
    L = DEPTH

    def nrm(k, shape, scale):
        return jax.random.normal(k, shape, f32) * scale

    a_c = jax.random.uniform(ks[9], (L, D_RNN), f32, 0.9, 0.999)
    a0 = a_c ** (1.0 / LRU_C)
    lru_lambda = jnp.log(a0) - jnp.log1p(-a0)
    return {
        "x": nrm(ks[0], (BATCH, SEQ, D_MODEL), 1.0),
        "mem": nrm(ks[1], (BATCH, N_MEM, D_MODEL), 1.0),
        "norm_mix_g": 1.0 + nrm(ks[2], (L, D_MODEL), 0.02),
        "w_in": nrm(ks[3], (L, D_MODEL, D_IN), D_MODEL ** -0.5),
        "conv_w": nrm(ks[4], (L, CONV_WIDTH, D_RNN), CONV_WIDTH ** -0.5),
        "conv_b": nrm(ks[5], (L, D_RNN), 0.01),
        "w_rg_a": nrm(ks[6], (L, RNN_HEADS, RNN_HEAD_DIM, RNN_HEAD_DIM), RNN_HEAD_DIM ** -0.5),
        "b_rg_a": nrm(ks[7], (L, D_RNN), 0.01),
        "w_rg_i": nrm(ks[8], (L, RNN_HEADS, RNN_HEAD_DIM, RNN_HEAD_DIM), RNN_HEAD_DIM ** -0.5),
        "b_rg_i": nrm(ks[10], (L, D_RNN), 0.01),
        "lru_lambda": lru_lambda,
        "w_pool": nrm(ks[11], (L, POOL_GROUPS, POOL_GROUP_DIM, POOL_GROUP_DIM), POOL_GROUP_DIM ** -0.5),
        "pool_scale": 1.0 + nrm(ks[12], (L, D_POOL), 0.1),
        "mem_norm_g": 1.0 + nrm(ks[13], (L, D_MODEL), 0.02),
        "w_mem_kv": nrm(ks[14], (L, D_MODEL, 2 * D_XATTN), D_MODEL ** -0.5),
        "w_out": nrm(ks[15], (L, D_MIX, D_MODEL), D_MIX ** -0.5),
        "norm_ffn_g": 1.0 + nrm(ks[16], (L, D_MODEL), 0.02),
        "w_router": nrm(ks[17], (L, D_MODEL, N_EXPERTS), D_MODEL ** -0.5),
        "b_router": nrm(ks[18], (L, N_EXPERTS), 0.01),
        "w_gu": nrm(ks[19], (L, N_EXPERTS, D_MODEL, 2 * D_FF), D_MODEL ** -0.5),
        "b_gu": nrm(ks[20], (L, N_EXPERTS, 2 * D_FF), 0.01),
        "w_down": nrm(ks[21], (L, N_EXPERTS, D_FF, D_MODEL), D_FF ** -0.5),
        "b_down": nrm(ks[22], (L, N_EXPERTS, D_MODEL), 0.01),
        "final_norm_g": 1.0 + nrm(ks[23], (D_MODEL,), 0.02),
    }


def reference(x, mem, norm_mix_g, w_in, conv_w, conv_b, w_rg_a, b_rg_a, w_rg_i, b_rg_i,
              lru_lambda, w_pool, pool_scale, mem_norm_g, w_mem_kv, w_out, norm_ffn_g,
              w_router, b_router, w_gu, b_gu, w_down, b_down, final_norm_g):
    for l in range(DEPTH):
        h = rmsnorm(x, norm_mix_g[l])
        proj = h @ w_in[l]
        u_rnn = proj[..., :D_RNN]
        g_rnn = proj[..., D_RNN:2 * D_RNN]
        u_pool = proj[..., 2 * D_RNN:2 * D_RNN + D_POOL]
        q_mem = proj[..., 2 * D_RNN + D_POOL:]
        y_rnn = rg_lru(causal_depthwise_conv(u_rnn, conv_w[l], conv_b[l]),
                       w_rg_a[l], b_rg_a[l], w_rg_i[l], b_rg_i[l], lru_lambda[l])
        y_rnn = y_rnn * jax.nn.gelu(g_rnn)
        y_pool = multiscale_pool(u_pool, w_pool[l], pool_scale[l])
        y_mem = memory_cross_attention(q_mem, rmsnorm(mem, mem_norm_g[l]), w_mem_kv[l])
        mixed = jnp.concatenate([y_rnn, y_pool, y_mem], axis=-1)
        x = x + mixed @ w_out[l]
        x = x + moe_ffn(rmsnorm(x, norm_ffn_g[l]), w_router[l], b_router[l],
                        w_gu[l], b_gu[l], w_down[l], b_down[l])
    return rmsnorm(x, final_norm_g)
```

```cpp
#include <hip/hip_runtime.h>
#include <cstdio>
#include <cstdint>


namespace {
constexpr int BATCH = 2, SEQ = 8192, D = 1024, T = BATCH * SEQ, NMEM = 256;
constexpr int DRNN = 512, NH = 8, DPOOL = 256, DX = 256, XH = 4, DIN = 1536;
constexpr int NE = 32, TOPK = 4, DFF = 1024, TK = T * TOPK;
constexpr float EPS = 1e-6f;
typedef _Float16 f16;
typedef _Float16 f16x2 __attribute__((ext_vector_type(2)));
typedef _Float16 f16x4 __attribute__((ext_vector_type(4)));
typedef _Float16 f16x8 __attribute__((ext_vector_type(8)));
typedef float f32x2 __attribute__((ext_vector_type(2)));
typedef float f32x4 __attribute__((ext_vector_type(4)));
typedef unsigned u32x4 __attribute__((ext_vector_type(4)));
typedef unsigned u32x2 __attribute__((ext_vector_type(2)));
#define LAS __attribute__((address_space(3)))

constexpr size_t MiB = 1u << 20;
constexpr size_t WS_CTL = 0;
constexpr size_t WS_LIST = 1 * MiB;
constexpr size_t WS_TOPE = 3 * MiB;
constexpr size_t WS_TOPG = 3 * MiB + 512 * 1024;
constexpr size_t WS_SMALLW = 4 * MiB;
constexpr size_t WS_WKVT = 5 * MiB;
constexpr size_t WS_MEMN = 6 * MiB;
constexpr size_t WS_KH = 7 * MiB;
constexpr size_t WS_VT = 7 * MiB + 512 * 1024;
constexpr size_t WS_WINT = 8 * MiB;
constexpr size_t WS_WOUTT = 11 * MiB;
constexpr size_t WS_AGG = 13 * MiB;
constexpr size_t WS_KVF = 14 * MiB;
constexpr size_t WS_GLIST = 14 * MiB;
constexpr size_t WS_WGUT = 16 * MiB;
constexpr size_t WS_WDT = 144 * MiB;
constexpr size_t WS_H0 = 208 * MiB;
constexpr size_t WS_PROJ = 240 * MiB;
constexpr size_t WS_PARTL = 288 * MiB;
constexpr size_t WS_SSQP = 296 * MiB;
constexpr size_t WS_RLIST = 297 * MiB;
constexpr size_t WS_MIXED = 352 * MiB;
constexpr size_t WS_X1 = 384 * MiB;
constexpr size_t WS_X1N = 448 * MiB;
constexpr size_t WS_HBUF = 482 * MiB;
constexpr size_t WS_Y = 626 * MiB;
constexpr size_t WS_END = 756 * MiB;
constexpr int CW_COUNTS = 0;
constexpr int CW_BAR = 4096;

struct Params {
    const float* in[24];
    float* out;
    unsigned char* ws;
    int ph_lo, ph_hi, flags, pad;
};

__device__ __forceinline__ float wave_sum(float v) {
#pragma unroll
    for (int o = 1; o < 64; o <<= 1) v += __shfl_xor(v, o);
    return v;
}
__device__ __forceinline__ float sigmoidf_(float x) { return 1.f / (1.f + expf(-x)); }
__device__ __forceinline__ unsigned pk_f16(float lo, float hi) { f32x2 v = {lo, hi}; f16x2 h = __builtin_convertvector(v, f16x2); return __builtin_bit_cast(unsigned, h); }
constexpr float SC_W = 64.f, SC_X = 16.f, SC_H = 4.f, SC_Y = 16.f;
__device__ __forceinline__ unsigned pk4_fp8(float a, float b, float c, float d) { int r = __builtin_amdgcn_cvt_pk_fp8_f32(a, b, 0, false); r = __builtin_amdgcn_cvt_pk_fp8_f32(c, d, r, true); return (unsigned)r; }
__device__ __forceinline__ float4 load4(const float* p) { return *(const float4*)p; }
__device__ __forceinline__ float4 load4(const f16* p) { const f16x4 h = *(const f16x4*)p; return make_float4((float)h[0], (float)h[1], (float)h[2], (float)h[3]); }
__device__ __forceinline__ void store4(float* p, float4 v) { *(float4*)p = v; }
__device__ __forceinline__ void store4(f16* p, float4 v) { u32x2 w; w.x = pk_f16(v.x, v.y); w.y = pk_f16(v.z, v.w); *(u32x2*)p = w; }
__device__ __forceinline__ int gu_dest_row(int n) { return n < DFF ? ((n >> 7) * 256 + (n & 127)) : (((n - DFF) >> 7) * 256 + 128 + ((n - DFF) & 127)); }

namespace pg {
constexpr int LDS_EPI = 139264 + 8192;
constexpr int LDS_PF_OFF = 139264 + 4096;
constexpr int BM = 256, BK = 64, HALF = 128, HTB = HALF * BK * 2, STAGE_BYTES = 8 * HTB, KD = 1024, NT = KD / BK;
constexpr unsigned ROWB = KD * 2;
constexpr unsigned ROWB8 = KD;
typedef int i32x8 __attribute__((ext_vector_type(8)));
__host__ __device__ __forceinline__ int lds_byte(int r, int c) { const int st = (r >> 4) * 2 + (c >> 5), rr = r & 15, cc = c & 31, ob = rr * 64 + cc * 2; return st * 1024 + (ob ^ (((ob >> 9) & 1) << 5)); }
__host__ __device__ __forceinline__ void stage_rc(int b, int& R, int& C) { const int st = b / 1024, sb = b % 1024, swz = sb ^ (((sb >> 9) & 1) << 5); R = (st >> 1) * 16 + swz / 64; C = (st & 1) * 32 + (swz % 64) / 2; }
__host__ __device__ __forceinline__ int perm32(int rho) { const int n = rho >> 4, i = rho & 15; return 8 * (i >> 2) + 4 * n + (i & 3); }

struct Unit { const char* A; const char* B; int kind, pm, pn, e, p0, cnt, hrow; };

__device__ __forceinline__ void glds16(const void* sbase, unsigned voff, unsigned lds_dst) {
    unsigned keep;
    asm volatile("s_mov_b32 %0, m0\n\ts_mov_b32 m0, %3\n\ts_nop 0\n\tglobal_load_lds_dwordx4 %1, %2\n\ts_mov_b32 m0, %0"
                 : "=&s"(keep) : "v"(voff), "s"(sbase), "s"(lds_dst) : "memory");
}
__device__ __forceinline__ const char* uptr(const char* p) {
    const unsigned long long v = (unsigned long long)(size_t)p;
    const unsigned lo = __builtin_amdgcn_readfirstlane((unsigned)v), hi = __builtin_amdgcn_readfirstlane((unsigned)(v >> 32));
    return (const char*)(size_t)(((unsigned long long)hi << 32) | lo);
}
__device__ __forceinline__ void glds4_prefetch(const void* sbase, unsigned voff, unsigned lds_dst) {
    unsigned keep;
    asm volatile("s_nop 4\n\ts_mov_b32 %0, m0\n\ts_mov_b32 m0, %3\n\ts_nop 0\n\tglobal_load_lds_dword %1, %2\n\ts_mov_b32 m0, %0"
                 : "=&s"(keep) : "v"(voff), "s"(sbase), "s"(lds_dst) : "memory");
}
__device__ __forceinline__ void glds16n(const void* sbase, unsigned voff, unsigned lds_dst) {
    unsigned keep;
    asm volatile("s_nop 4\n\ts_mov_b32 %0, m0\n\ts_mov_b32 m0, %3\n\ts_nop 0\n\tglobal_load_lds_dwordx4 %1, %2\n\ts_mov_b32 m0, %0"
                 : "=&s"(keep) : "v"(voff), "s"(sbase), "s"(lds_dst) : "memory");
}
template <class Sched, class Epi>
__device__ __forceinline__ void gemm_phase(LAS unsigned char* lds, const Sched& S, const Epi& E) {
    constexpr bool FP8 = Epi::FP8, GATHER = Sched::GATHER;
    constexpr unsigned ROWB_ = FP8 ? ROWB8 : ROWB;
    constexpr int NT_ = FP8 ? (KD / 128) : (KD / BK);
    const int tid = threadIdx.x, wid = __builtin_amdgcn_readfirstlane(tid >> 6), lane = tid & 63, wr = wid >> 2, wc = wid & 3, fr = lane & 15, fq = lane >> 4;
    int R0, C0; stage_rc(tid * 16, R0, C0);
    const unsigned colb = (unsigned)C0 * 2u;
    const unsigned voffA0 = (unsigned)R0 * ROWB_ + colb;
    const unsigned voffB0 = (unsigned)(Epi::PERM ? ((R0 & ~31) + perm32(R0 & 31)) : R0) * ROWB_ + colb;
    unsigned arow[4], arowN[4];
    const size_t kstep = (size_t)(BK * 2);
    const size_t hstepB = (size_t)HALF * ROWB_, qstep = (size_t)64 * ROWB_;
    const unsigned ldsb = (unsigned)(size_t)lds + (unsigned)wid * 1024u;
    const int aoff = lds_byte(wr * 64 + fr, fq * 8), boff = lds_byte(wc * 32 + fr, fq * 8);
#define PG_SA(b, h) (((b) * 2 + (h)) * HTB)
#define PG_SB(b, h) ((4 + (b) * 2 + (h)) * HTB)
#define PG_STAGEB(bufoff, gbase) do { glds16((const char*)(gbase), voffB0, ldsb + (bufoff)); glds16((const char*)(gbase) + qstep, voffB0, ldsb + (bufoff) + 8192); } while (0)
#define PG_STAGEA(bufoff, gbase, r0_, r1_, h) do { \
        if constexpr (GATHER) { glds16((const char*)(gbase), (r0_), ldsb + (bufoff)); glds16((const char*)(gbase), (r1_), ldsb + (bufoff) + 8192); } \
        else { glds16((const char*)(gbase) + (2 * (h)) * qstep, voffA0, ldsb + (bufoff)); glds16((const char*)(gbase) + (2 * (h) + 1) * qstep, voffA0, ldsb + (bufoff) + 8192); } } while (0)
#define PG_LDA(dst, b, h) do { _Pragma("unroll") for (int m = 0; m < 4; ++m) { \
        if constexpr (FP8) { const u32x4 lo_ = *(const LAS u32x4*)(lds + PG_SA(b, h) + aoff + m * 2048), hi_ = *(const LAS u32x4*)(lds + PG_SA(b, h) + aoff + m * 2048 + 1024); dst##8[m] = __builtin_shufflevector(lo_, hi_, 0, 1, 2, 3, 4, 5, 6, 7); } \
        else { _Pragma("unroll") for (int k = 0; k < 2; ++k) dst[m][k] = *(const LAS f16x8*)(lds + PG_SA(b, h) + aoff + m * 2048 + k * 1024); } } } while (0)
#define PG_LDB(dst, b, h) do { _Pragma("unroll") for (int n = 0; n < 2; ++n) { \
        if constexpr (FP8) { const u32x4 lo_ = *(const LAS u32x4*)(lds + PG_SB(b, h) + boff + n * 2048), hi_ = *(const LAS u32x4*)(lds + PG_SB(b, h) + boff + n * 2048 + 1024); dst##8[n] = __builtin_shufflevector(lo_, hi_, 0, 1, 2, 3, 4, 5, 6, 7); } \
        else { _Pragma("unroll") for (int k = 0; k < 2; ++k) dst[n][k] = *(const LAS f16x8*)(lds + PG_SB(b, h) + boff + n * 2048 + k * 1024); } } } while (0)
#define PG_MMA(ai, bj, At, Bt) do { __builtin_amdgcn_s_setprio(1); _Pragma("unroll") for (int m = 0; m < 4; ++m) _Pragma("unroll") for (int n = 0; n < 2; ++n) { \
        if constexpr (FP8) asm volatile("v_mfma_scale_f32_16x16x128_f8f6f4 %0, %1, %2, %0, %3, %3 op_sel_hi:[0,0,0]" : "+v"(acc[ai][bj][m][n]) : "v"(Bt##8[n]), "v"(At##8[m]), "v"(mxscale)); \
        else { _Pragma("unroll") for (int k = 0; k < 2; ++k) acc[ai][bj][m][n] = __builtin_amdgcn_mfma_f32_16x16x32_f16(Bt[n][k], At[m][k], acc[ai][bj][m][n], 0, 0, 0); } } \
        __builtin_amdgcn_s_setprio(0); } while (0)
#define PG_WAIT_V(n) asm volatile("s_waitcnt vmcnt(" #n ")" ::: "memory")
#define PG_WAIT_L(n) asm volatile("s_waitcnt lgkmcnt(" #n ")" ::: "memory")
#define PG_BAR __builtin_amdgcn_s_barrier()
#define PG_SCHED __builtin_amdgcn_sched_barrier(0)
    Unit cur, nxt; int ui = 0;
    if (!S.next(0, cur)) return;
    if constexpr (GATHER) S.rows(cur, R0, colb, arow);
    f32x4 acc[2][2][4][2];
    f16x8 At[4][2], B0[2][2], B1[2][2];
    typedef unsigned u32x8 __attribute__((ext_vector_type(8)));
    u32x8 At8[4], B08[2], B18[2];
    unsigned mxscale = 0x7F7F7F7Fu; asm volatile("" : "+v"(mxscale));
    const char* cA = cur.A; const char* cB = cur.B;
    PG_WAIT_V(0);
    E.init(acc, cur, wr, wc, fr, fq);
    E.prefetch(cur, wid, lane, (unsigned)(size_t)lds + (unsigned)LDS_EPI);
    PG_STAGEB(PG_SB(0, 0), cB); PG_STAGEB(PG_SB(0, 1), cB + hstepB); PG_STAGEA(PG_SA(0, 0), cA, arow[0], arow[1], 0); PG_STAGEA(PG_SA(0, 1), cA, arow[2], arow[3], 1);
    if (wr == 1) PG_BAR;
    PG_WAIT_V(2); PG_BAR;
    PG_STAGEB(PG_SB(1, 0), cB + kstep); PG_STAGEA(PG_SA(1, 0), cA + kstep, arow[0], arow[1], 0); PG_STAGEB(PG_SB(1, 1), cB + hstepB + kstep);
    PG_WAIT_V(6); PG_BAR;
#pragma unroll
    for (int a = 0; a < 2; ++a)
#pragma unroll
        for (int b = 0; b < 2; ++b)
            asm volatile("" : "+v"(acc[a][b][0][0]), "+v"(acc[a][b][0][1]), "+v"(acc[a][b][1][0]), "+v"(acc[a][b][1][1]), "+v"(acc[a][b][2][0]), "+v"(acc[a][b][2][1]), "+v"(acc[a][b][3][0]), "+v"(acc[a][b][3][1]));
    for (;;) {
        const bool has_next = S.next(ui + 1, nxt);
        const char* nA = has_next ? nxt.A : cA; const char* nB = has_next ? nxt.B : cB;
        const int hf_ = Sched::HALVES ? __builtin_amdgcn_readfirstlane(cur.kind) : 0;
        unsigned rawN[4];
        if constexpr (GATHER) {
            if (has_next) S.rows_issue(nxt, R0, rawN);
            else {
#pragma unroll
                for (int q = 0; q < 4; ++q) arowN[q] = arow[q];
            }
        }
#pragma unroll 1
        for (int t = 0; t < NT_; t += 2) {
            const bool last = (t == NT_ - 2);
            if (t == 2 && has_next) E.prefetch(nxt, wid, lane, (unsigned)(size_t)lds + (unsigned)LDS_EPI + (unsigned)(((ui + 1) & 1) * 4096));
            if constexpr (GATHER) {
                if (last && has_next) {
                    asm volatile("s_waitcnt vmcnt(8)" : "+v"(rawN[0]), "+v"(rawN[1]), "+v"(rawN[2]), "+v"(rawN[3]) :: "memory");
                    S.rows_finish(nxt, R0, colb, rawN, arowN);
                }
            }
            const char* a1 = cA + (size_t)(t + 1) * kstep;
            const char* a2 = last ? nA : cA + (size_t)(t + 2) * kstep; const char* b2 = last ? nB : cB + (size_t)(t + 2) * kstep;
            const char* a3 = a2 + kstep; const char* b3 = b2 + kstep;
            PG_LDB(B0, 0, 0); PG_LDB(B1, 0, 1); PG_SCHED; PG_LDA(At, 0, 0); PG_STAGEA(PG_SA(1, 1), a1, arow[2], arow[3], 1);
            PG_WAIT_V(8); PG_WAIT_L(0); PG_BAR; if (!Sched::HALVES || hf_ != 2) { PG_MMA(0, 0, At, B0); PG_MMA(0, 1, At, B1); } PG_BAR; PG_SCHED;
            PG_LDA(At, 0, 1); PG_STAGEB(PG_SB(0, 0), b2); PG_STAGEB(PG_SB(0, 1), b2 + hstepB); PG_STAGEA(PG_SA(0, 0), a2, (last ? arowN[0] : arow[0]), (last ? arowN[1] : arow[1]), 0);
            PG_WAIT_V(8); PG_WAIT_L(0); PG_BAR; if (!Sched::HALVES || hf_ != 1) { PG_MMA(1, 0, At, B0); PG_MMA(1, 1, At, B1); } PG_BAR; PG_SCHED;
            PG_LDB(B0, 1, 0); PG_LDB(B1, 1, 1); PG_SCHED; PG_LDA(At, 1, 0); PG_STAGEA(PG_SA(0, 1), a2, (last ? arowN[2] : arow[2]), (last ? arowN[3] : arow[3]), 1);
            PG_WAIT_V(8); PG_WAIT_L(0); PG_BAR; if (!Sched::HALVES || hf_ != 2) { PG_MMA(0, 0, At, B0); PG_MMA(0, 1, At, B1); } PG_BAR; PG_SCHED;
            PG_LDA(At, 1, 1); PG_STAGEB(PG_SB(1, 0), b3); PG_STAGEB(PG_SB(1, 1), b3 + hstepB); PG_STAGEA(PG_SA(1, 0), a3, (last ? arowN[0] : arow[0]), (last ? arowN[1] : arow[1]), 0);
            PG_WAIT_V(8); PG_WAIT_L(0); PG_BAR; if (!Sched::HALVES || hf_ != 1) { PG_MMA(1, 0, At, B0); PG_MMA(1, 1, At, B1); } PG_BAR; PG_SCHED;
        }
        if constexpr (Sched::PREFETCH) {
            if (has_next) {
                const unsigned pf_lds = (unsigned)(size_t)lds + (unsigned)(LDS_PF_OFF) + (unsigned)wid * 256u;
                if constexpr (GATHER) { if ((wid & 1) == 0) { const unsigned q = (unsigned)lane & 3u; const unsigned ro = (q == 0 ? arowN[0] : q == 1 ? arowN[1] : q == 2 ? arowN[2] : arowN[3]) - colb; glds4_prefetch(uptr(nA + 128 * nxt.pn), ro, pf_lds); } }
                else { const unsigned t_ = (unsigned)tid & 255u, k_ = (unsigned)(2 * nxt.pn) + ((unsigned)tid >> 8); glds4_prefetch(uptr(nA), t_ * ROWB_ + 128u * k_, pf_lds); }
            }
        }
        if (wr == 0) PG_BAR;
        if constexpr (FP8) asm volatile("s_nop 15\n\ts_nop 15" ::: "memory");
        E(acc, cur, wr, wc, fr, fq, lds + LDS_EPI + (ui & 1) * 4096);
        if (!has_next) break;
        E.init(acc, nxt, wr, wc, fr, fq);
        cur = nxt; cA = nA; cB = nB; ++ui;
        if constexpr (GATHER) {
#pragma unroll
            for (int q = 0; q < 4; ++q) arow[q] = arowN[q];
        }
        if (wr == 1) PG_BAR;
    }
    PG_WAIT_V(0);
    PG_BAR;
#undef PG_SA
#undef PG_SB
#undef PG_STAGEA
#undef PG_STAGEB
#undef PG_LDA
#undef PG_LDB
#undef PG_MMA
#undef PG_WAIT_V
#undef PG_WAIT_L
#undef PG_BAR
#undef PG_SCHED
}

__device__ __forceinline__ void zero_acc(f32x4 (&acc)[2][2][4][2]) {
#pragma unroll
    for (int a = 0; a < 2; ++a)
#pragma unroll
        for (int b = 0; b < 2; ++b)
#pragma unroll
            for (int m = 0; m < 4; ++m)
#pragma unroll
                for (int n = 0; n < 2; ++n) acc[a][b][m][n] = (f32x4){0.f, 0.f, 0.f, 0.f};
}
template <unsigned RB = ROWB> __device__ __forceinline__ void dense_rows(int R0, unsigned colb, unsigned (&ar)[4]) {
#pragma unroll
    for (int q = 0; q < 4; ++q) ar[q] = (unsigned)(R0 + 64 * q) * RB + colb;
}
}

constexpr int NWAVES = 8;
constexpr int RING_BYTES = 131072;
constexpr int LDS_CTL_OFF = 139264;
constexpr int LDS_EPI_OFF = LDS_CTL_OFF + 8192;
constexpr int LDS_BYTES = 163840;

#define XB_TMO      128
#define XB_XCNT(j)  (256  + 64 * (j))
#define XB_XSUB(j)  (1280 + 64 * (j))
#define XB_XGEN(j)  (2304 + 64 * (j))
#define XB_TOP      3328
#define XB_TOPGEN   3392
#define XCD_BAR_WORDS 3456
#define XB_SPIN_CAP (1u << 18)
__device__ __forceinline__ unsigned xb_ld(unsigned* p)              { return __hip_atomic_load(p, __ATOMIC_RELAXED, __HIP_MEMORY_SCOPE_AGENT); }
__device__ __forceinline__ unsigned xb_add(unsigned* p, unsigned v) { return __hip_atomic_fetch_add(p, v, __ATOMIC_RELAXED, __HIP_MEMORY_SCOPE_AGENT); }
__device__ __forceinline__ unsigned xb_xcc_id() { return (unsigned)__builtin_amdgcn_s_getreg((3 << 11) | 20) & 0xFu; }
#define XB_SPIN(cond, bar) do { unsigned _sp = 0; while (cond) { __builtin_amdgcn_s_sleep(1); \
    if ((++_sp & 255u) == 0u) { if (xb_ld(&(bar)[XB_TMO])) break; if (_sp > XB_SPIN_CAP) { atomicAdd(&(bar)[XB_TMO], 1u); break; } } } } while (0)
struct XcdBarrier { unsigned* bar; unsigned x; volatile LAS unsigned* st; };
__device__ __forceinline__ XcdBarrier xcd_barrier_post(unsigned* bar, volatile LAS unsigned* st) {
    XcdBarrier b; b.bar = bar; b.x = xb_xcc_id(); b.st = st;
    if (threadIdx.x == 0) (void)xb_add(&bar[XB_XCNT(b.x)], 1u);
    return b;
}
__device__ __forceinline__ void xcd_barrier_complete(unsigned* bar, unsigned x, unsigned& nloc, unsigned& nx) {
    const unsigned G = gridDim.x * gridDim.y * gridDim.z;
    unsigned sum, cnt, mine, sp = 0u;
    for (;;) {
        sum = 0u; cnt = 0u; mine = 0u;
#pragma unroll
        for (unsigned j = 0; j < 16; ++j) { const unsigned c = xb_ld(&bar[XB_XCNT(j)]); sum += c; cnt += (c > 0u) ? 1u : 0u; mine = (j == x) ? c : mine; }
        if (sum == G) break;
        __builtin_amdgcn_s_sleep(1);
        if ((++sp & 255u) == 0u) { if (xb_ld(&bar[XB_TMO])) break; if (sp > XB_SPIN_CAP) { atomicAdd(&bar[XB_TMO], 1u); break; } }
    }
    nloc = mine > 0u ? mine : 1u; nx = cnt > 0u ? cnt : 1u;
}
__device__ __forceinline__ void xcd_barrier(const XcdBarrier& b) {
    asm volatile("s_waitcnt vmcnt(0)" ::: "memory");
    __syncthreads();
    if (threadIdx.x == 0) {
        unsigned* bar = b.bar;
        __builtin_amdgcn_s_waitcnt(0);
        unsigned nloc = b.st[0], nx = b.st[1];
        if (nloc == 0u) { xcd_barrier_complete(bar, b.x, nloc, nx); b.st[0] = nloc; b.st[1] = nx; }
        const unsigned old = xb_add(&bar[XB_XSUB(b.x)], 1u);
        const unsigned gen = old / nloc;
        if (old + 1u == (gen + 1u) * nloc) {
            __builtin_amdgcn_fence(__ATOMIC_RELEASE, "agent");
            asm volatile("s_waitcnt vmcnt(0)" ::: "memory");
            const unsigned og = xb_add(&bar[XB_TOP], 1u);
            const unsigned tg = og / nx;
            if (og + 1u == (tg + 1u) * nx) xb_add(&bar[XB_TOPGEN], 1u);
            else XB_SPIN(xb_ld(&bar[XB_TOPGEN]) == tg, bar);
            __builtin_amdgcn_fence(__ATOMIC_ACQUIRE, "agent");
            xb_add(&bar[XB_XGEN(b.x)], 1u);
            asm volatile("s_waitcnt vmcnt(0)" ::: "memory");
        } else {
            XB_SPIN(xb_ld(&bar[XB_XGEN(b.x)]) == gen, bar);
            __builtin_amdgcn_fence(__ATOMIC_ACQUIRE, "agent");
            asm volatile("s_waitcnt vmcnt(0)" ::: "memory");
        }
    }
    __syncthreads();
}

struct Frame {
    LAS unsigned char* lds;
    unsigned* ctl;
    unsigned char* ws;
    int tid, lane, wave, vcu, G, bx;
    const float* const* in;
    float* out;
    int flags;
};

__device__ __forceinline__ void p0_transpose_item(const float* __restrict__ src, int ld, int k0, int n0, f16* __restrict__ dst, int drow0, LAS unsigned* scr, int lane) {
    const int n4 = lane & 15, rr = lane >> 4;
    const float* s0 = src + (size_t)(k0 + 2 * rr) * ld + n0 + 4 * n4;
#pragma unroll 4
    for (int it = 0; it < 16; ++it) {
        const float4 v0 = *(const float4*)(s0 + (size_t)(8 * it) * ld);
        const float4 v1 = *(const float4*)(s0 + (size_t)(8 * it + 1) * ld);
        const int kp = it * 4 + rr;
        scr[(4 * n4 + 0) * 65 + kp] = pk_f16(v0.x, v1.x);
        scr[(4 * n4 + 1) * 65 + kp] = pk_f16(v0.y, v1.y);
        scr[(4 * n4 + 2) * 65 + kp] = pk_f16(v0.z, v1.z);
        scr[(4 * n4 + 3) * 65 + kp] = pk_f16(v0.w, v1.w);
    }
    asm volatile("s_waitcnt lgkmcnt(0)" ::: "memory");
    const int c = lane & 15, nl = lane >> 4;
#pragma unroll 4
    for (int jt = 0; jt < 16; ++jt) {
        const int n = jt * 4 + nl;
        u32x4 o; o.x = scr[n * 65 + 4 * c + 0]; o.y = scr[n * 65 + 4 * c + 1]; o.z = scr[n * 65 + 4 * c + 2]; o.w = scr[n * 65 + 4 * c + 3];
        *(u32x4*)(dst + (size_t)(drow0 + n) * 1024 + k0 + 8 * c) = o;
    }
    asm volatile("s_waitcnt lgkmcnt(0)" ::: "memory");
}
__device__ __forceinline__ void p0_transpose_item_fp8(const float* __restrict__ src, int ld, int k0, int n0, unsigned char* __restrict__ dst, int drow0, float sc, LAS unsigned* scr, int lane) {
    const int n4 = lane & 15, rr = lane >> 4;
    const float* s0 = src + (size_t)(k0 + 4 * rr) * ld + n0 + 4 * n4;
#pragma unroll 4
    for (int it = 0; it < 16; ++it) {
        const float* sp = s0 + (size_t)(16 * it) * ld;
        typedef float f4nt __attribute__((ext_vector_type(4)));
        const f4nt n0_ = __builtin_nontemporal_load((const f4nt*)(sp)), n1_ = __builtin_nontemporal_load((const f4nt*)(sp + ld)), n2_ = __builtin_nontemporal_load((const f4nt*)(sp + 2 * (size_t)ld)), n3_ = __builtin_nontemporal_load((const f4nt*)(sp + 3 * (size_t)ld));
        const float4 v0 = {n0_[0], n0_[1], n0_[2], n0_[3]}, v1 = {n1_[0], n1_[1], n1_[2], n1_[3]}, v2 = {n2_[0], n2_[1], n2_[2], n2_[3]}, v3 = {n3_[0], n3_[1], n3_[2], n3_[3]};
        const int kq = it * 4 + rr;
        scr[(4 * n4 + 0) * 65 + kq] = pk4_fp8(v0.x * sc, v1.x * sc, v2.x * sc, v3.x * sc);
        scr[(4 * n4 + 1) * 65 + kq] = pk4_fp8(v0.y * sc, v1.y * sc, v2.y * sc, v3.y * sc);
        scr[(4 * n4 + 2) * 65 + kq] = pk4_fp8(v0.z * sc, v1.z * sc, v2.z * sc, v3.z * sc);
        scr[(4 * n4 + 3) * 65 + kq] = pk4_fp8(v0.w * sc, v1.w * sc, v2.w * sc, v3.w * sc);
    }
    asm volatile("s_waitcnt lgkmcnt(0)" ::: "memory");
    const int c = lane & 15, nl = lane >> 4;
#pragma unroll 4
    for (int jt = 0; jt < 16; ++jt) {
        const int n = jt * 4 + nl;
        u32x4 o; o.x = scr[n * 65 + 4 * c + 0]; o.y = scr[n * 65 + 4 * c + 1]; o.z = scr[n * 65 + 4 * c + 2]; o.w = scr[n * 65 + 4 * c + 3];
        __builtin_nontemporal_store(o, (u32x4*)(dst + (size_t)(drow0 + n) * 1024 + k0 + 16 * c));
    }
    asm volatile("s_waitcnt lgkmcnt(0)" ::: "memory");
}
__device__ __forceinline__ void rms_row_f16(const float* __restrict__ xrow, const float* __restrict__ g, f16* __restrict__ orow, int lane) {
    const f32x4* xr = (const f32x4*)xrow + lane;
    f32x4 v[4]; float s = 0.f;
#pragma unroll
    for (int j = 0; j < 4; ++j) { v[j] = __builtin_nontemporal_load(xr + 64 * j); s += (v[j].x * v[j].x + v[j].y * v[j].y) + (v[j].z * v[j].z + v[j].w * v[j].w); }
    const float rstd = rsqrtf(wave_sum(s) * (1.f / D) + EPS);
    u32x2* o8 = (u32x2*)orow + lane;
#pragma unroll
    for (int j = 0; j < 4; ++j) { const f32x4 gg = ((const f32x4*)g)[lane + 64 * j]; u32x2 w; w.x = pk_f16(v[j].x * rstd * gg.x, v[j].y * rstd * gg.y); w.y = pk_f16(v[j].z * rstd * gg.z, v[j].w * rstd * gg.w); o8[64 * j] = w; }
}
constexpr int P0_IGU = NE * 4 * (2 * DFF / 64), P0_IDN = NE * 4 * (D / 64), P0_IEXP = P0_IGU + P0_IDN;
constexpr int P1_NGEMM = 192;
constexpr int P1_IDLE0 = P1_NGEMM + 4;
constexpr int P1_ITEMS_PER_WAVE = 2;
constexpr int P0_DEFER = (256 - P1_IDLE0) * 8 * P1_ITEMS_PER_WAVE;
__device__ __forceinline__ void p0_expert_item(Frame& F, int r, LAS unsigned* scr) {
    const float* w_gu = F.in[19]; const float* w_down = F.in[21];
    unsigned char* WguT = F.ws + WS_WGUT; unsigned char* WdT = F.ws + WS_WDT;
    if (r < P0_IGU) { const int e = r / (4 * 32), q = r % (4 * 32), nb = q & 31, kb = q >> 5;
        p0_transpose_item_fp8(w_gu + (size_t)e * D * 2 * DFF, 2 * DFF, kb * 256, nb * 64, WguT + (size_t)e * 2 * DFF * 1024, gu_dest_row(nb * 64), SC_W, scr, F.lane); }
    else { r -= P0_IGU; const int e = r / (4 * 16), q = r % (4 * 16), nb = q & 15, kb = q >> 4; p0_transpose_item_fp8(w_down + (size_t)e * DFF * D, D, kb * 256, nb * 64, WdT + (size_t)e * D * 1024, nb * 64, SC_W, scr, F.lane); }
}
typedef float f4nt __attribute__((ext_vector_type(4)));
struct ExpItem { const float* s0; size_t ld; unsigned char* dst; };
__device__ __forceinline__ ExpItem exp_item(Frame& F, int r) {
    const float* w_gu = F.in[19]; const float* w_down = F.in[21];
    const int n4 = F.lane & 15, rr = F.lane >> 4;
    ExpItem I;
    if (r < P0_IGU) { const int e = r / (4 * 32), q = r % (4 * 32), nb = q & 31, kb = q >> 5;
        I.ld = 2 * DFF; I.s0 = w_gu + (size_t)e * D * 2 * DFF + (size_t)(kb * 256 + 4 * rr) * (2 * DFF) + nb * 64 + 4 * n4; I.dst = F.ws + WS_WGUT + (size_t)e * 2 * DFF * 1024 + (size_t)gu_dest_row(nb * 64) * 1024 + kb * 256; }
    else { r -= P0_IGU; const int e = r / (4 * 16), q = r % (4 * 16), nb = q & 15, kb = q >> 4;
        I.ld = D; I.s0 = w_down + (size_t)e * DFF * D + (size_t)(kb * 256 + 4 * rr) * D + nb * 64 + 4 * n4; I.dst = F.ws + WS_WDT + (size_t)e * D * 1024 + (size_t)(nb * 64) * 1024 + kb * 256; }
    return I;
}
__device__ __forceinline__ void exp_issue(const ExpItem& I, int b, f4nt (&buf)[16]) {
#pragma unroll
    for (int i = 0; i < 4; ++i) { const float* sp = I.s0 + (size_t)(16 * (4 * b + i)) * I.ld;
#pragma unroll
        for (int j = 0; j < 4; ++j) buf[4 * i + j] = __builtin_nontemporal_load((const f4nt*)(sp + j * I.ld)); }
}
__device__ __forceinline__ void exp_consume(const f4nt (&buf)[16], int b, LAS unsigned* scr, int lane) {
    const int n4 = lane & 15, rr = lane >> 4;
#pragma unroll
    for (int i = 0; i < 4; ++i) { const int kq = (4 * b + i) * 4 + rr;
#pragma unroll
        for (int c = 0; c < 4; ++c) scr[(4 * n4 + c) * 65 + kq] = pk4_fp8(buf[4 * i][c] * SC_W, buf[4 * i + 1][c] * SC_W, buf[4 * i + 2][c] * SC_W, buf[4 * i + 3][c] * SC_W); }
}
__device__ __forceinline__ void exp_flush(const ExpItem& I, LAS unsigned* scr, int lane) {
    asm volatile("s_waitcnt lgkmcnt(0)" ::: "memory");
    const int c = lane & 15, nl = lane >> 4;
#pragma unroll 4
    for (int jt = 0; jt < 16; ++jt) {
        const int n = jt * 4 + nl;
        u32x4 o; o.x = scr[n * 65 + 4 * c + 0]; o.y = scr[n * 65 + 4 * c + 1]; o.z = scr[n * 65 + 4 * c + 2]; o.w = scr[n * 65 + 4 * c + 3];
        __builtin_nontemporal_store(o, (u32x4*)(I.dst + (size_t)n * 1024 + 16 * c));
    }
    asm volatile("s_waitcnt lgkmcnt(0)" ::: "memory");
}
__device__ __forceinline__ void p0_expert_run(Frame& F, int base, int start, int stride, int end, LAS unsigned* scr) {
    int it = start;
    if (it >= end) return;
    ExpItem cur = exp_item(F, base + it), nxt = cur;
    f4nt A[16], B[16];
    exp_issue(cur, 0, A);
    for (;;) {
        const int itn = it + stride; const bool has = itn < end;
        if (has) nxt = exp_item(F, base + itn);
        exp_issue(cur, 1, B); exp_consume(A, 0, scr, F.lane);
        exp_issue(cur, 2, A); exp_consume(B, 1, scr, F.lane);
        exp_issue(cur, 3, B); exp_consume(A, 2, scr, F.lane);
        if (has) exp_issue(nxt, 0, A);
        exp_consume(B, 3, scr, F.lane);
        exp_flush(cur, scr, F.lane);
        if (!has) break;
        cur = nxt; it = itn;
    }
}
__device__ __forceinline__ void p1_deferred_items(Frame& F) {
    if (F.G != 256 || F.bx < P1_IDLE0) { if (F.G != 256) { LAS unsigned* scr = (LAS unsigned*)(F.lds + F.wave * 16896); p0_expert_run(F, P0_IEXP - P0_DEFER, F.vcu * NWAVES + F.wave, F.G * NWAVES, P0_DEFER, scr); } return; }
    LAS unsigned* scr = (LAS unsigned*)(F.lds + F.wave * 16896);
    p0_expert_run(F, P0_IEXP - P0_DEFER, (F.bx - P1_IDLE0) * NWAVES + F.wave, (256 - P1_IDLE0) * NWAVES, P0_DEFER, scr);
}
__device__ __forceinline__ void p0_prologue(Frame& F) {
    LAS unsigned* scr = (LAS unsigned*)(F.lds + F.wave * 16896);
    const int gw = F.vcu * NWAVES + F.wave, NGW = F.G * NWAVES;
    const float* w_in = F.in[3]; const float* w_kv = F.in[14]; const float* w_out = F.in[15];
    f16* WinT = (f16*)(F.ws + WS_WINT); f16* WoutT = (f16*)(F.ws + WS_WOUTT); f16* WkvT = (f16*)(F.ws + WS_WKVT);
    constexpr int I_IN = 8 * (DIN / 64), I_OUT = 8 * (D / 64), I_KV = 8 * (2 * DX / 64);
    constexpr int NITEMS = I_IN + I_OUT + I_KV + (P0_IEXP - P0_DEFER);
    p0_expert_run(F, 0, gw, NGW, P0_IEXP - P0_DEFER, scr);
    for (int it = (P0_IEXP - P0_DEFER) / NGW * NGW + gw; it < NITEMS; it += NGW) {
        int r = it;
        if (r < P0_IEXP - P0_DEFER) continue;
        r -= (P0_IEXP - P0_DEFER);
        if (r < I_IN) { const int nb = r >> 3, kb = r & 7; p0_transpose_item(w_in, DIN, kb * 128, nb * 64, WinT, nb * 64, scr, F.lane); continue; } r -= I_IN;
        if (r < I_OUT) { const int nb = r >> 3, kb = r & 7; p0_transpose_item(w_out, D, kb * 128, nb * 64, WoutT, nb * 64, scr, F.lane); continue; } r -= I_OUT;
        { const int nb = r >> 3, kb = r & 7; p0_transpose_item(w_kv, 2 * DX, kb * 128, nb * 64, WkvT, nb * 64, scr, F.lane); }
    }
    f16* H0 = (f16*)(F.ws + WS_H0); f16* MEMN = (f16*)(F.ws + WS_MEMN);
    for (int m = gw; m < T + BATCH * NMEM; m += NGW) {
        if (m < T) rms_row_f16(F.in[0] + (size_t)m * D, F.in[2], H0 + (size_t)m * D, F.lane);
        else rms_row_f16(F.in[1] + (size_t)(m - T) * D, F.in[13], MEMN + (size_t)(m - T) * D, F.lane);
    }
    { unsigned long long* agz = (unsigned long long*)(F.ws + WS_AGG) + (size_t)F.bx * DRNN; if (F.bx < T / 64) agz[F.tid] = 0ull; if (F.bx < 16) agz[(size_t)256 * DRNN + F.tid] = 0ull; }
    if (gw == 0) { u32x4* z = (u32x4*)(F.ws + WS_X1N + (size_t)T * D); z[F.lane] = (u32x4){0u, 0u, 0u, 0u}; if (F.lane == 0) ((float*)(F.ws + WS_TOPG))[TK] = 0.f; }
}

struct SchedP1 {
    static constexpr bool GATHER = false, PREFETCH = false, HALVES = false;
    const char* H0; const char* WinT; const char* MEMN; const char* WkvT; int G, c;
    __device__ __forceinline__ bool next(int i, pg::Unit& u) const {
        constexpr int NP = 64 * 6;
        int L;
        if (G == 256) {
            if (c < P1_NGEMM) { L = i * P1_NGEMM + c; if (L >= NP) return false; }
            else { if (i > 0 || c >= P1_NGEMM + 4) return false; L = NP + (c - P1_NGEMM); }
        } else { L = i * G + c; if (L >= NP + 4) return false; }
        if (L < NP) {
            int wgid = L; { const int q = NP / 8, xcd = wgid % 8, off = wgid / 8; wgid = xcd * q + off; }
            const int nig = 8 * 6, gid = wgid / nig, fm = gid * 8;
            u.pm = fm + ((wgid % nig) % 8); u.pn = (wgid % nig) / 8; u.kind = 0;
            u.A = H0 + (size_t)u.pm * 256 * pg::ROWB; u.B = WinT + (size_t)u.pn * 256 * pg::ROWB;
                    u.e = 0; u.hrow = u.pm * 256; u.p0 = u.pn * 256; u.cnt = DIN;
        } else {
            const int q = L - NP, b = q >> 1, v = q & 1; u.pm = b; u.pn = v; u.kind = 1; u.e = 1 + q; u.hrow = 0; u.p0 = 0; u.cnt = DX;
            const char* mb = MEMN + (size_t)b * 256 * pg::ROWB; const char* wv = WkvT + (size_t)v * 256 * pg::ROWB;
            u.A = v ? wv : mb; u.B = v ? mb : wv; }
        return true;
    }
    __device__ __forceinline__ void rows(const pg::Unit&, int R0, unsigned colb, unsigned (&ar)[4]) const { pg::dense_rows(R0, colb, ar); }
};
struct EpiP1 {
    static constexpr bool PERM = true, FP8 = false;
    f16* proj; f16* Kh; f16* VT;
    __device__ __forceinline__ void init(f32x4 (&acc)[2][2][4][2], const pg::Unit&, int, int, int, int) const { pg::zero_acc(acc); }
    __device__ __forceinline__ void prefetch(const pg::Unit&, int, int, unsigned) const {}
    __device__ __forceinline__ void operator()(const f32x4 (&acc)[2][2][4][2], const pg::Unit& u, int wr, int wc, int fr, int fq, const LAS unsigned char*) const {
        f16* base = proj;
        if (u.e != 0) { const int q = u.e - 1; base = ((q & 1) ? VT : Kh) + (size_t)(q >> 1) * NMEM * DX; }
        const int ld = u.cnt;
        const int row0 = u.hrow + wr * 64 + fr, col0 = u.p0 + wc * 32 + 8 * fq;
#pragma unroll
        for (int ai = 0; ai < 2; ++ai)
#pragma unroll
            for (int m = 0; m < 4; ++m) { f16* rowp = base + (size_t)(row0 + ai * 128 + m * 16) * ld + col0;
#pragma unroll
                for (int bj = 0; bj < 2; ++bj) { const f32x4 v0 = acc[ai][bj][m][0], v1 = acc[ai][bj][m][1];
                    u32x4 w; w.x = pk_f16(v0[0], v0[1]); w.y = pk_f16(v0[2], v0[3]); w.z = pk_f16(v1[0], v1[1]); w.w = pk_f16(v1[2], v1[3]);
                    *(u32x4*)(rowp + bj * 128) = w; } }
    }
};

struct SchedP3 {
    static constexpr bool GATHER = false, PREFETCH = false, HALVES = false;
    const char* MIX; const char* WoutT; int L;
    __device__ __forceinline__ bool next(int i, pg::Unit& u) const {
        constexpr int NP = 64 * 4;
        if (i > 0 || L >= NP) return false;
        int wgid = L; { const int q = NP / 8, xcd = wgid % 8, off = wgid / 8; wgid = xcd * q + off; }
        const int nig = 8 * 4, gid = wgid / nig, fm = gid * 8;
        u.pm = fm + ((wgid % nig) % 8); u.pn = (wgid % nig) / 8; u.kind = 0;
        u.A = MIX + (size_t)u.pm * 256 * pg::ROWB; u.B = WoutT + (size_t)u.pn * 256 * pg::ROWB;
        u.e = 0; u.p0 = 0; u.cnt = 0; u.hrow = 0;
        return true;
    }
    __device__ __forceinline__ void rows(const pg::Unit&, int R0, unsigned colb, unsigned (&ar)[4]) const { pg::dense_rows(R0, colb, ar); }
};
struct EpiP3 {
    static constexpr bool PERM = true, FP8 = false;
    const float* x; f16* x1; unsigned char* x1g8; const float* gffn; const f16* WrH; float* PARTL; float* SSQP; LAS unsigned char* lds;
    __device__ __forceinline__ void init(f32x4 (&acc)[2][2][4][2], const pg::Unit& u, int wr, int wc, int fr, int fq) const {
        const float* xp = x + (size_t)(u.pm * 256 + wr * 64 + fr) * D + u.pn * 256 + wc * 32 + 8 * fq;
#pragma unroll
        for (int ai = 0; ai < 2; ++ai)
#pragma unroll
            for (int m = 0; m < 4; ++m)
#pragma unroll
                for (int bj = 0; bj < 2; ++bj)
#pragma unroll
                    for (int n = 0; n < 2; ++n) acc[ai][bj][m][n] = __builtin_nontemporal_load((const f32x4*)(xp + (size_t)(ai * 128 + m * 16) * D + bj * 128 + 4 * n));
    }
    __device__ __forceinline__ void prefetch(const pg::Unit&, int, int, unsigned) const {}
    __device__ __forceinline__ void operator()(const f32x4 (&acc)[2][2][4][2], const pg::Unit& u, int wr, int wc, int fr, int fq, const LAS unsigned char*) const {
        const int wave = wr * 4 + wc;
        const int row0 = u.pm * 256 + wr * 64 + fr, col0 = u.pn * 256 + wc * 32 + 8 * fq;
        f16x8 wrh[2][2], wrl[2][2];
        f32x4 gg[2][2];
#pragma unroll
        for (int bj = 0; bj < 2; ++bj) {
#pragma unroll
            for (int eh = 0; eh < 2; ++eh) { const size_t o = (size_t)(16 * eh + fr) * D + col0 + 128 * bj; wrh[bj][eh] = *(const f16x8*)(WrH + o); wrl[bj][eh] = *(const f16x8*)(WrH + (size_t)NE * D + o); }
            gg[bj][0] = *(const f32x4*)(gffn + col0 + 128 * bj) * SC_X; gg[bj][1] = *(const f32x4*)(gffn + col0 + 128 * bj + 4) * SC_X;
        }
        asm volatile("s_waitcnt vmcnt(0)" ::: "memory");
        __builtin_amdgcn_s_barrier();
        LAS float* PL = (LAS float*)lds + wave * (128 * 32);
        LAS float* SS = (LAS float*)(lds + LDS_EPI_OFF) + wave * 128;
#pragma unroll
        for (int ai = 0; ai < 2; ++ai)
#pragma unroll
            for (int p = 0; p < 2; ++p) {
                u32x2 wv[2][2];
#pragma unroll
                for (int mm = 0; mm < 2; ++mm) {
                    const int m = 2 * p + mm;
                    const size_t off = (size_t)(row0 + ai * 128 + m * 16) * D + col0;
                    f32x4 L0 = {0.f, 0.f, 0.f, 0.f}, L1 = {0.f, 0.f, 0.f, 0.f}; float ss = 0.f;
#pragma unroll
                    for (int bj = 0; bj < 2; ++bj) {
                        const f32x4 v0 = acc[ai][bj][m][0], v1 = acc[ai][bj][m][1];
                        u32x4 w; w.x = pk_f16(v0[0], v0[1]); w.y = pk_f16(v0[2], v0[3]); w.z = pk_f16(v1[0], v1[1]); w.w = pk_f16(v1[2], v1[3]);
                        *(u32x4*)(x1 + off + bj * 128) = w;
                        const f16x8 hv = __builtin_bit_cast(f16x8, w);
                        const f32x4 h0 = {(float)hv[0], (float)hv[1], (float)hv[2], (float)hv[3]}, h1 = {(float)hv[4], (float)hv[5], (float)hv[6], (float)hv[7]};
                        ss += ((h0[0] * h0[0] + h0[1] * h0[1]) + (h0[2] * h0[2] + h0[3] * h0[3])) + ((h1[0] * h1[0] + h1[1] * h1[1]) + (h1[2] * h1[2] + h1[3] * h1[3]));
                        const f32x4 q0 = h0 * gg[bj][0], q1 = h1 * gg[bj][1];
                        wv[mm][bj].x = pk4_fp8(q0[0], q0[1], q0[2], q0[3]); wv[mm][bj].y = pk4_fp8(q1[0], q1[1], q1[2], q1[3]);
                        L0 = __builtin_amdgcn_mfma_f32_16x16x32_f16(wrh[bj][0], hv, L0, 0, 0, 0); L1 = __builtin_amdgcn_mfma_f32_16x16x32_f16(wrh[bj][1], hv, L1, 0, 0, 0);
                        L0 = __builtin_amdgcn_mfma_f32_16x16x32_f16(wrl[bj][0], hv, L0, 0, 0, 0); L1 = __builtin_amdgcn_mfma_f32_16x16x32_f16(wrl[bj][1], hv, L1, 0, 0, 0);
                    }
                    const int rl = (ai * 4 + m) * 16 + fr;
                    *(LAS f32x4*)(PL + rl * 32 + 4 * fq) = L0; *(LAS f32x4*)(PL + rl * 32 + 16 + 4 * fq) = L1;
                    ss += __shfl_xor(ss, 16); ss += __shfl_xor(ss, 32);
                    if (fq == 0) SS[rl] = ss;
                }
#pragma unroll
                for (int bj = 0; bj < 2; ++bj) {
                    const auto rx = __builtin_amdgcn_permlane16_swap(wv[0][bj].x, wv[1][bj].x, false, false);
                    const auto ry = __builtin_amdgcn_permlane16_swap(wv[0][bj].y, wv[1][bj].y, false, false);
                    const int r = row0 + ai * 128 + (2 * p + (fq & 1)) * 16;
                    u32x4 w16; w16.x = rx[0]; w16.y = ry[0]; w16.z = rx[1]; w16.w = ry[1];
                    *(u32x4*)(x1g8 + (size_t)r * D + u.pn * 256 + wc * 32 + 16 * (fq >> 1) + bj * 128) = w16;
                }
            }
        asm volatile("s_waitcnt lgkmcnt(0)" ::: "memory");
        __builtin_amdgcn_s_barrier();
        {
            const int t = (int)threadIdx.x, r256 = t >> 1, eh = t & 1;
            const int ai_ = r256 >> 7, wr_ = (r256 >> 6) & 1, rl = (ai_ * 4 + ((r256 >> 4) & 3)) * 16 + (r256 & 15);
            const LAS float* pl = (const LAS float*)lds + (wr_ * 4) * (128 * 32) + rl * 32 + 16 * eh;
            const size_t grow = (size_t)u.pn * T + (size_t)u.pm * 256 + r256;
#pragma unroll
            for (int q = 0; q < 4; ++q) {
                f32x4 sum = *(const LAS f32x4*)(pl + 4 * q);
#pragma unroll
                for (int c = 1; c < 4; ++c) sum += *(const LAS f32x4*)(pl + c * (128 * 32) + 4 * q);
                *(f32x4*)(PARTL + grow * 32 + 16 * eh + 4 * q) = sum;
            }
            if (eh == 0) { const LAS float* sp = (const LAS float*)(lds + LDS_EPI_OFF) + (wr_ * 4) * 128 + rl; SSQP[grow] = ((sp[0] + sp[128]) + sp[256]) + sp[384]; }
        }
    }
};

template <int NCT, bool GATHER_> struct SchedMoe {
    static constexpr bool GATHER = GATHER_, PREFETCH = true, HALVES = true;
    const char* Abase; const char* Wbase; size_t wstride_e; const int* list; const LAS int* tab; int G, c;
    __device__ __forceinline__ bool next(int i, pg::Unit& u) const {
        const int ntiles = __builtin_amdgcn_readfirstlane(tab[NE]);
        const int per = G >> 3;
        const int U = ntiles * NCT, Uc = (U + 7) / 8, x = c & 7, j = c >> 3;
        int Ux = U - x * Uc; Ux = Ux < 0 ? 0 : (Ux > Uc ? Uc : Ux);
        const int nfull = Ux / per, rem = Ux - nfull * per;
        int Lx, half = 0;
        if (i < nfull) Lx = j + per * i;
        else if (i == nfull && rem > 0) {
            if (2 * rem <= per) { if (j >= 2 * rem) return false; Lx = nfull * per + (j >> 1); half = 1 + (j & 1); }
            else { if (j >= rem) return false; Lx = nfull * per + j; }
        } else return false;
        const int L = x * Uc + Lx;
        const int RT = L / NCT, ct = L % NCT;
        const int ln = (int)(threadIdx.x & 63u);
        const unsigned long long mm = __ballot((ln < NE) && (tab[ln & 31] <= RT));
        const int e = 63 - __builtin_clzll(mm);
        const int t0 = __builtin_amdgcn_readfirstlane(tab[e]);
        u.e = e; u.p0 = (RT - t0) * 256; u.cnt = __builtin_amdgcn_readfirstlane(tab[40 + e]); u.hrow = RT * 256; u.pn = ct; u.pm = RT;
        if (half == 0 && u.cnt - u.p0 <= 128) half = 1;
        u.kind = half;
        u.B = Wbase + (size_t)e * wstride_e + (size_t)ct * 256 * pg::ROWB8;
        u.A = GATHER_ ? Abase : Abase + (size_t)u.hrow * pg::ROWB8;
        return true;
    }
    __device__ __forceinline__ void rows_issue(const pg::Unit& u, int R0, unsigned (&raw)[4]) const {
        const int idx = __builtin_amdgcn_readfirstlane(u.e * T + u.p0);
        const char* lb = (const char*)(list + idx);
        const unsigned off = (unsigned)R0 * 4u;
        asm volatile("global_load_dword %0, %4, %5\n\tglobal_load_dword %1, %4, %5 offset:256\n\tglobal_load_dword %2, %4, %5 offset:512\n\tglobal_load_dword %3, %4, %5 offset:768"
                     : "=&v"(raw[0]), "=&v"(raw[1]), "=&v"(raw[2]), "=&v"(raw[3]) : "v"(off), "s"(lb) : "memory");
    }
    __device__ __forceinline__ void rows_finish(const pg::Unit& u, int R0, unsigned colb, const unsigned (&raw)[4], unsigned (&ar)[4]) const {
#pragma unroll
        for (int q = 0; q < 4; ++q) { const int pos = u.p0 + R0 + 64 * q; const unsigned tok = (pos < u.cnt) ? (raw[q] >> 2) : (unsigned)T; ar[q] = tok * pg::ROWB8 + colb; }
    }
    __device__ __forceinline__ void rows(const pg::Unit& u, int R0, unsigned colb, unsigned (&ar)[4]) const {
        if (GATHER_) {
#pragma unroll
            for (int q = 0; q < 4; ++q) { const int pos = u.p0 + R0 + 64 * q; const int posc = pos < u.cnt ? pos : u.cnt - 1; const int le = list[u.e * T + posc]; const int tok = pos < u.cnt ? (le >> 2) : T; ar[q] = (unsigned)tok * pg::ROWB8 + colb; }
        } else pg::dense_rows<pg::ROWB8>(R0, colb, ar);
    }
};
struct EpiGU {
    static constexpr bool PERM = true, FP8 = true;
    const float* b_gu; const float* rlist; unsigned char* Hbuf; int skip;
    __device__ __forceinline__ void init(f32x4 (&acc)[2][2][4][2], const pg::Unit&, int, int, int, int) const { pg::zero_acc(acc); }
    __device__ __forceinline__ void prefetch(const pg::Unit& u, int wid, int lane, unsigned slot) const {
        if (wid == 0) { const unsigned voff = (unsigned)((lane < 32 ? (u.pn * 128 + 4 * lane) : (DFF + u.pn * 128 + 4 * (lane - 32))) * 4); pg::glds16n(pg::uptr((const char*)(b_gu + (size_t)u.e * 2 * DFF)), voff, slot);
            pg::glds16n(pg::uptr((const char*)(rlist + (size_t)u.e * T + u.p0)), (unsigned)lane * 16u, slot + 1024u); }
    }
    __device__ __forceinline__ void operator()(const f32x4 (&acc)[2][2][4][2], const pg::Unit& u, int wr, int wc, int fr, int fq, const LAS unsigned char* slot) const {
        if (skip) return;
        const int cj = u.pn * 128 + wc * 32 + 8 * fq;
        f32x4 bgv[2], buv[2];
#pragma unroll
        for (int n = 0; n < 2; ++n) { bgv[n] = *(const LAS f32x4*)(slot + (wc * 32 + 8 * fq + 4 * n) * 4); buv[n] = *(const LAS f32x4*)(slot + 512 + (wc * 32 + 8 * fq + 4 * n) * 4); }
        const int cj16 = u.pn * 128 + wc * 32 + 16 * (fq >> 1);
#pragma unroll
        for (int ai = 0; ai < 2; ++ai) {
            if (u.kind == 2 - ai) continue;
            u32x2 wv[4];
#pragma unroll
            for (int m = 0; m < 4; ++m) {
                float o[8];
                const int rl = ai * 128 + wr * 64 + m * 16 + fr;
                const float rsc = ((u.p0 + rl) < u.cnt ? ((const LAS float*)(slot + 1024))[rl] : 0.f) * (1.f / (SC_W * SC_X));
#pragma unroll
                for (int n = 0; n < 2; ++n)
#pragma unroll
                    for (int j = 0; j < 4; ++j) {
                        float gv = __builtin_fmaf(acc[ai][0][m][n][j], rsc, bgv[n][j]), uv = __builtin_fmaf(acc[ai][1][m][n][j], rsc, buv[n][j]);
                        gv = fminf(gv, 7.f); uv = __builtin_amdgcn_fmed3f(uv, -7.f, 7.f);
                        const float sg = __builtin_amdgcn_rcpf(1.f + __builtin_amdgcn_exp2f(gv * (-1.702f * 1.4426950408889634f)));
                        o[4 * n + j] = __builtin_fmaf(uv, SC_H, SC_H) * (gv * sg);
                    }
                wv[m].x = pk4_fp8(o[0], o[1], o[2], o[3]); wv[m].y = pk4_fp8(o[4], o[5], o[6], o[7]);
            }
#pragma unroll
            for (int p = 0; p < 2; ++p) {
                const auto rx = __builtin_amdgcn_permlane16_swap(wv[2 * p].x, wv[2 * p + 1].x, false, false);
                const auto ry = __builtin_amdgcn_permlane16_swap(wv[2 * p].y, wv[2 * p + 1].y, false, false);
                const int r = ai * 128 + wr * 64 + (2 * p + (fq & 1)) * 16 + fr;
                u32x4 w16; w16.x = rx[0]; w16.y = ry[0]; w16.z = rx[1]; w16.w = ry[1];
                *(u32x4*)(Hbuf + (size_t)(u.hrow + r) * DFF + cj16) = w16;
            }
        }
    }
};
struct EpiDown {
    static constexpr bool PERM = true, FP8 = true;
    const float* b_down; const int* list; const float* glist; unsigned char* Y; int skip;
    __device__ __forceinline__ void init(f32x4 (&acc)[2][2][4][2], const pg::Unit&, int, int, int, int) const { pg::zero_acc(acc); }
    __device__ __forceinline__ void prefetch(const pg::Unit& u, int wid, int lane, unsigned slot) const {
        if (wid == 0) { const unsigned voff = (unsigned)lane * 16u;
            pg::glds16n(pg::uptr((const char*)(b_down + (size_t)u.e * D + u.pn * 256)), voff, slot);
            pg::glds16n(pg::uptr((const char*)(list + (size_t)u.e * T + u.p0)), voff, slot + 1024u);
            pg::glds16n(pg::uptr((const char*)(glist + (size_t)u.e * T + u.p0)), voff, slot + 2048u); }
    }
    __device__ __forceinline__ void operator()(const f32x4 (&acc)[2][2][4][2], const pg::Unit& u, int wr, int wc, int fr, int fq, const LAS unsigned char* slotp) const {
        if (skip) return;
        const int c0 = u.pn * 256 + wc * 32 + 8 * fq;
        f32x4 bv[2][2];
#pragma unroll
        for (int bj = 0; bj < 2; ++bj)
#pragma unroll
            for (int n = 0; n < 2; ++n) bv[bj][n] = *(const LAS f32x4*)(slotp + (bj * 128 + wc * 32 + 8 * fq + 4 * n) * 4);
        const int c16 = u.pn * 256 + wc * 32 + 16 * (fq >> 1);
#pragma unroll
        for (int ai = 0; ai < 2; ++ai) {
            if (u.kind == 2 - ai) continue;
#pragma unroll
            for (int p = 0; p < 2; ++p) {
                const int rA = ai * 128 + wr * 64 + (2 * p) * 16 + fr, rB = rA + 16;
                const int slA = ((const LAS int*)(slotp + 1024))[rA], slB = ((const LAS int*)(slotp + 1024))[rB];
                const float glA = ((const LAS float*)(slotp + 2048))[rA], glB = ((const LAS float*)(slotp + 2048))[rB];
                const bool okA = (u.p0 + rA) < u.cnt, okB = (u.p0 + rB) < u.cnt;
                const int slotA = okA ? slA : TK, slotB = okB ? slB : TK;
                const float gtA = (okA ? glA : 0.f) * SC_Y, gtB = (okB ? glB : 0.f) * SC_Y;
                const int slot = (fq & 1) ? slotB : slotA;
                unsigned char* rowp = Y + (size_t)slot * D + c16;
#pragma unroll
                for (int bj = 0; bj < 2; ++bj) {
                    const f32x4 a0 = (acc[ai][bj][2 * p][0] * (1.f / (SC_W * SC_H)) + bv[bj][0]) * gtA, a1 = (acc[ai][bj][2 * p][1] * (1.f / (SC_W * SC_H)) + bv[bj][1]) * gtA;
                    const f32x4 b0 = (acc[ai][bj][2 * p + 1][0] * (1.f / (SC_W * SC_H)) + bv[bj][0]) * gtB, b1 = (acc[ai][bj][2 * p + 1][1] * (1.f / (SC_W * SC_H)) + bv[bj][1]) * gtB;
                    const unsigned ax = pk4_fp8(a0[0], a0[1], a0[2], a0[3]), ay = pk4_fp8(a1[0], a1[1], a1[2], a1[3]);
                    const unsigned bx = pk4_fp8(b0[0], b0[1], b0[2], b0[3]), by = pk4_fp8(b1[0], b1[1], b1[2], b1[3]);
                    const auto rx = __builtin_amdgcn_permlane16_swap(ax, bx, false, false);
                    const auto ry = __builtin_amdgcn_permlane16_swap(ay, by, false, false);
                    u32x4 w16; w16.x = rx[0]; w16.y = ry[0]; w16.z = rx[1]; w16.w = ry[1];
                    *(u32x4*)(rowp + bj * 128) = w16;
                }
            }
        }
    }
};
__device__ __forceinline__ void moe_table(Frame& F) {
    LAS int* tab = (LAS int*)(F.lds + LDS_CTL_OFF + 256);
    if (F.tid == 0) { int tt = 0; for (int e = 0; e < NE; ++e) { const int c = (int)F.ctl[CW_COUNTS + 64 * e]; tab[e] = tt; tab[40 + e] = c; tt += (c + 255) >> 8; } tab[NE] = tt; }
    __syncthreads();
}

constexpr size_t SW_WAT = 0, SW_WIT = 64 * 1024, SW_WPT = 128 * 1024, SW_WRP = 256 * 1024;
__device__ __forceinline__ void p0_small(Frame& F) {
    const int gt = F.vcu * (NWAVES * 64) + F.tid, NTH = F.G * NWAVES * 64;
    f16* WaT = (f16*)(F.ws + WS_SMALLW + SW_WAT); f16* WiT = (f16*)(F.ws + WS_SMALLW + SW_WIT); f16* WpT = (f16*)(F.ws + WS_SMALLW + SW_WPT); f16* WrH = (f16*)(F.ws + WS_SMALLW + SW_WRP); f16* WrL = WrH + NE * D;
    const float* w_a = F.in[6]; const float* w_i = F.in[8]; const float* w_p = F.in[11]; const float* gffn = F.in[16]; const float* w_r = F.in[17];
    for (int idx = gt; idx < NH * 64 * 64; idx += NTH) { const int h = idx >> 12, j = (idx >> 6) & 63, i = idx & 63; WaT[idx] = (f16)w_a[(h * 64 + i) * 64 + j]; WiT[idx] = (f16)w_i[(h * 64 + i) * 64 + j]; }
    for (int idx = gt; idx < 4 * 64 * 64; idx += NTH) { const int g = idx >> 12, j = (idx >> 6) & 63, i = idx & 63; WpT[idx] = (f16)w_p[(g * 64 + i) * 64 + j]; }
    for (int idx = gt; idx < D * NE; idx += NTH) { const int k = idx >> 5, e = idx & 31; const float wv = 1024.f * (gffn[k] * w_r[idx]); const f16 hh = (f16)wv; WrH[e * D + k] = hh; WrL[e * D + k] = (f16)(wv - (float)hh); }
}

typedef float f32x16 __attribute__((ext_vector_type(16)));
constexpr int UCS_PITCH = 520;
constexpr int DT_PITCH = 264;
constexpr int P2_DT_OFF = 64 * UCS_PITCH * 2;
constexpr int P2_STG_OFF = P2_DT_OFF + 64 * DT_PITCH * 2;
constexpr float LOG2E = 1.4426950408889634f;
__device__ __forceinline__ float sigmoid_fast(float x) { return __builtin_amdgcn_rcpf(1.f + __builtin_amdgcn_exp2f(-x * LOG2E)); }
__device__ __forceinline__ float gelu_tanh_fast(float x) {
    const float u2 = 1.5957691216057308f * (x + 0.044715f * x * x * x);
    return x * sigmoid_fast(u2);
}
template <int W> __device__ __forceinline__ void pool_d2(const unsigned* up2, int tpos0, LAS unsigned* dst) {
    f32x2 u[16 + W - 1];
#pragma unroll
    for (int i = 0; i < 16 + W - 1; ++i) {
        const int rel = i - (W - 1), lim = -tpos0, rc = rel < lim ? lim : rel;
        const unsigned ld = up2[(ptrdiff_t)rc * (DIN / 2)];
        const unsigned raw = (rel >= lim) ? ld : 0u;
        const f16x2 h = __builtin_bit_cast(f16x2, raw);
        u[i] = (f32x2){(float)h[0], (float)h[1]};
    }
#pragma unroll
    for (int t = 0; t < 16; ++t) {
        f32x2 sacc = {0.f, 0.f};
#pragma unroll
        for (int q = 0; q < W; ++q) sacc += u[t + (W - 1) - q];
        const int n = (tpos0 + t + 1 < W) ? (tpos0 + t + 1) : W;
        const float rn = 1.f / (float)n;
        const f32x2 d = sacc * rn - u[t + W - 1];
        dst[t * (DT_PITCH / 2)] = pk_f16(d[0], d[1]);
    }
}
__device__ __forceinline__ void lookback16(const unsigned long long* base, int n, float& la, float& lh) {
    unsigned long long g[16];
    for (unsigned spin = 0;; ++spin) {
        bool ok = true;
#pragma unroll
        for (int i = 0; i < 16; ++i) { const int k = i < n ? i : (n > 0 ? n - 1 : 0);
            g[i] = __hip_atomic_load((unsigned long long*)base + (size_t)k * DRNN, __ATOMIC_RELAXED, __HIP_MEMORY_SCOPE_AGENT);
            if (i < n) ok = ok && ((unsigned)g[i] != 0u); }
        if (ok || spin > (1u << 18)) break;
        __builtin_amdgcn_s_sleep(2);
    }
    la = 1.f; lh = 0.f;
#pragma unroll
    for (int i = 0; i < 16; ++i) if (i < n) { const float a = __uint_as_float((unsigned)g[i]), hh = __uint_as_float((unsigned)(g[i] >> 32)); lh = a * lh + hh; la = a * la; }
}
__device__ __forceinline__ void p2_mixer(Frame& F) {
    const f16* proj = (const f16*)(F.ws + WS_PROJ);
    f16* mixed = (f16*)(F.ws + WS_MIXED);
    unsigned long long* AGG = (unsigned long long*)(F.ws + WS_AGG);
    const f16* WaT = (const f16*)(F.ws + WS_SMALLW + SW_WAT); const f16* WiT = (const f16*)(F.ws + WS_SMALLW + SW_WIT); const f16* WpT = (const f16*)(F.ws + WS_SMALLW + SW_WPT);
    const f16* Kh = (const f16*)(F.ws + WS_KH); const f16* VT = (const f16*)(F.ws + WS_VT);
    const float* conv_w = F.in[4]; const float* conv_b = F.in[5]; const float* b_a = F.in[7]; const float* b_i = F.in[9]; const float* lam = F.in[10]; const float* pool_scale = F.in[12];
    LAS f16* ucs = (LAS f16*)(F.lds); LAS f16* dts = (LAS f16*)(F.lds + P2_DT_OFF);
    const int w = F.wave;
    const int sub = F.flags ? F.flags : 31;
    for (int ch = F.bx; ch < T / 64; ch += F.G) {
        int tid = F.tid; asm volatile("" : "+v"(tid));
        const int lane = tid & 63, hi = lane >> 5, l31 = lane & 31;
        const int tok0 = ch * 64, t0 = tok0 % SEQ, b = tok0 / SEQ;
        if (sub & 1) {
            const int cp = tid & 255, th = tid >> 8, c0 = 2 * cp;
            const f32x2 cw0 = *(const f32x2*)(conv_w + c0), cw1 = *(const f32x2*)(conv_w + DRNN + c0), cw2 = *(const f32x2*)(conv_w + 2 * DRNN + c0), cw3 = *(const f32x2*)(conv_w + 3 * DRNN + c0), cbv = *(const f32x2*)(conv_b + c0);
            const unsigned* up2 = (const unsigned*)(proj + (size_t)(tok0 + 32 * th) * DIN + c0);
            unsigned raw[35];
#pragma unroll
            for (int i = 0; i < 35; ++i) {
                const int rel = i - 3, lim = -(t0 + 32 * th), rc = rel < lim ? lim : rel;
                const unsigned v = up2[(ptrdiff_t)rc * (DIN / 2)];
                raw[i] = (rel >= lim) ? v : 0u;
            }
            LAS unsigned* dstc = (LAS unsigned*)(ucs + (32 * th) * UCS_PITCH + c0);
            f32x2 u0, u1, u2;
            { const f16x2 h0 = __builtin_bit_cast(f16x2, raw[0]), h1 = __builtin_bit_cast(f16x2, raw[1]), h2 = __builtin_bit_cast(f16x2, raw[2]);
              u0 = (f32x2){(float)h0[0], (float)h0[1]}; u1 = (f32x2){(float)h1[0], (float)h1[1]}; u2 = (f32x2){(float)h2[0], (float)h2[1]}; }
#pragma unroll
            for (int t = 0; t < 32; ++t) {
                const f16x2 h3 = __builtin_bit_cast(f16x2, raw[t + 3]);
                const f32x2 u3 = (f32x2){(float)h3[0], (float)h3[1]};
                const f32x2 v = cbv + cw0 * u0 + cw1 * u1 + cw2 * u2 + cw3 * u3;
                dstc[t * (UCS_PITCH / 2)] = pk_f16(v[0], v[1]);
                u0 = u1; u1 = u2; u2 = u3;
            }
        }
        if (sub & 2) {
            const int g = w & 3, half = w >> 2, cpl = lane & 31, q2 = lane >> 5, ts = 32 * half + 16 * q2, c0 = 64 * g + 2 * cpl;
            const unsigned* pp2 = (const unsigned*)(proj + (size_t)(tok0 + ts) * DIN + 2 * DRNN + c0);
            LAS unsigned* dst = (LAS unsigned*)(dts + ts * DT_PITCH + c0);
            if (g == 0) pool_d2<2>(pp2, t0 + ts, dst); else if (g == 1) pool_d2<4>(pp2, t0 + ts, dst); else if (g == 2) pool_d2<8>(pp2, t0 + ts, dst); else pool_d2<16>(pp2, t0 + ts, dst);
        }
        __syncthreads();
        unsigned sth_[4][8], stp_[4][8];
#pragma unroll
        for (int a = 0; a < 4; ++a)
#pragma unroll
            for (int q = 0; q < 8; ++q) { sth_[a][q] = 0u; stp_[a][q] = 0u; }
        float ownA = 1.f, ownH = 0.f;
        if (sub & 4) {
            const int h = w;
#pragma unroll 1
            for (int cb = 0; cb < 2; ++cb) {
                const int cch = 64 * h + 32 * cb + l31;
                const float ba = b_a[cch], bi = b_i[cch];
                const float sp8 = -8.f * log1pf(expf(-lam[cch]));
                f16x8 wa[4], wi[4], idv[2];
#pragma unroll
                for (int s = 0; s < 4; ++s) {
                    wa[s] = *(const f16x8*)(WaT + ((size_t)(h * 64 + 32 * cb + l31) * 64 + 16 * s + 8 * hi));
                    wi[s] = *(const f16x8*)(WiT + ((size_t)(h * 64 + 32 * cb + l31) * 64 + 16 * s + 8 * hi));
                }
#pragma unroll
                for (int ss = 0; ss < 2; ++ss) {
                    const int jj = l31 - 16 * ss - 8 * hi;
#pragma unroll
                    for (int j = 0; j < 8; ++j) idv[ss][j] = (j == jj) ? (f16)1.f : (f16)0.f;
                }
                float cc = 0.f, Q = 1.f;
#pragma unroll 1
                for (int tb = 0; tb < 2; ++tb) {
                    const LAS f16* arow_ = ucs + (32 * tb + l31) * UCS_PITCH + 64 * h + 8 * hi;
                    f32x16 ar, ai, au;
#pragma unroll
                    for (int r = 0; r < 16; ++r) { ar[r] = 0.f; ai[r] = 0.f; au[r] = 0.f; }
#pragma unroll
                    for (int s = 0; s < 4; ++s) {
                        const f16x8 af = *(const LAS f16x8*)(arow_ + 16 * s);
                        ar = __builtin_amdgcn_mfma_f32_32x32x16_f16(af, wa[s], ar, 0, 0, 0);
                        ai = __builtin_amdgcn_mfma_f32_32x32x16_f16(af, wi[s], ai, 0, 0, 0);
                        if ((s >> 1) == cb) au = __builtin_amdgcn_mfma_f32_32x32x16_f16(af, idv[s & 1], au, 0, 0, 0);
                    }
                    const int tbase = tok0 + 32 * tb + 4 * hi;
                    const f16* gp = proj + (size_t)tbase * DIN + DRNN + cch;
#pragma unroll
                    for (int r = 0; r < 16; ++r) {
                        const int dt = (r & 3) + 8 * (r >> 2);
                        const float rr = sigmoid_fast(ar[r] + ba), ii = sigmoid_fast(ai[r] + bi);
                        const float la = sp8 * rr;
                        const float a = __builtin_amdgcn_exp2f(la * LOG2E);
                        float mult = __builtin_amdgcn_sqrtf(fmaxf(__builtin_fmaf(-a, a, 1.f), 0.f));
                        if (t0 + 32 * tb + 4 * hi + dt == 0) mult = 1.f;
                        ar[r] = a; ai[r] = mult * (ii * au[r]);
                        au[r] = gelu_tanh_fast((float)gp[(size_t)dt * DIN]);
                    }
                    float cin[4], Qin[4];
#pragma unroll
                    for (int rg = 0; rg < 4; ++rg) {
                        float P = ar[4 * rg], hh = ai[4 * rg];
#pragma unroll
                        for (int q = 1; q < 4; ++q) { const float a = ar[4 * rg + q]; hh = a * hh + ai[4 * rg + q]; P = a * P; ar[4 * rg + q] = P; ai[4 * rg + q] = hh; }
                        const float oA = __shfl_xor(P, 32), oH = __shfl_xor(hh, 32);
                        const float A0 = hi ? oA : P, H0 = hi ? oH : hh;
                        const float A1 = hi ? P : oA, H1 = hi ? hh : oH;
                        const float c0 = cc, q0 = Q;
                        cc = A0 * cc + H0; Q = Q * A0;
                        const float c1 = cc, q1 = Q;
                        cc = A1 * cc + H1; Q = Q * A1;
                        cin[rg] = hi ? c1 : c0; Qin[rg] = hi ? q1 : q0;
                    }
#pragma unroll
                    for (int q = 0; q < 8; ++q) { sth_[3][q] = sth_[2][q]; sth_[2][q] = sth_[1][q]; sth_[1][q] = sth_[0][q]; stp_[3][q] = stp_[2][q]; stp_[2][q] = stp_[1][q]; stp_[1][q] = stp_[0][q]; }
#pragma unroll
                    for (int q = 0; q < 8; ++q) {
                        const int r0 = 2 * q, r1 = 2 * q + 1;
                        const float hl0 = ai[r0] + ar[r0] * cin[r0 >> 2], hl1 = ai[r1] + ar[r1] * cin[r1 >> 2];
                        const float pc0 = ar[r0] * Qin[r0 >> 2], pc1 = ar[r1] * Qin[r1 >> 2];
                        sth_[0][q] = pk_f16(hl0 * au[r0], hl1 * au[r1]); stp_[0][q] = pk_f16(pc0 * au[r0], pc1 * au[r1]);
                    }
                }
                if (hi == 0) __hip_atomic_store(AGG + ch * DRNN + cch, ((unsigned long long)__float_as_uint(cc) << 32) | (unsigned long long)__float_as_uint(Q), __ATOMIC_RELAXED, __HIP_MEMORY_SCOPE_AGENT);
                if (cb == hi) { ownA = Q; ownH = cc; }
            }
        }
        const int first = (ch / (SEQ / 64)) * (SEQ / 64), rel = ch - first, grp = rel >> 4, gi = rel & 15, gbase = first + 16 * grp;
        const unsigned long long* agc = AGG + lane + 64 * w;
        unsigned long long* AGG2 = AGG + 256 * DRNN;
        float la = 1.f, lh = 0.f;
        if ((sub & 4) && gi == 15) {
            lookback16(agc + (size_t)gbase * DRNN, 15, la, lh);
            const float ta = ownA * la, thh = ownA * lh + ownH;
            __hip_atomic_store(AGG2 + (size_t)((ch / (SEQ / 64)) * 8 + grp) * DRNN + lane + 64 * w, ((unsigned long long)__float_as_uint(thh) << 32) | __float_as_uint(ta), __ATOMIC_RELAXED, __HIP_MEMORY_SCOPE_AGENT);
        }
        if (sub & 8) {
            const int g = w & 3, th = w >> 2;
            f16x8 Bf[4];
#pragma unroll
            for (int s = 0; s < 4; ++s) Bf[s] = *(const LAS f16x8*)(dts + (32 * th + l31) * DT_PITCH + 64 * g + 16 * s + 8 * hi);
            const size_t tok = (size_t)(tok0 + 32 * th + l31);
#pragma unroll
            for (int cb = 0; cb < 2; ++cb) {
                f32x16 acc;
#pragma unroll
                for (int r = 0; r < 16; ++r) acc[r] = 0.f;
#pragma unroll
                for (int s = 0; s < 4; ++s) { const f16x8 wf = *(const f16x8*)(WpT + ((size_t)(g * 64 + 32 * cb + l31) * 64 + 16 * s + 8 * hi)); acc = __builtin_amdgcn_mfma_f32_32x32x16_f16(wf, Bf[s], acc, 0, 0, 0); }
#pragma unroll
                for (int rg = 0; rg < 4; ++rg) {
                    const int j0 = 32 * cb + 8 * rg + 4 * hi;
                    const f32x4 sc = *(const f32x4*)(pool_scale + 64 * g + j0);
                    u32x2 o; o.x = pk_f16(acc[4 * rg] * sc[0], acc[4 * rg + 1] * sc[1]); o.y = pk_f16(acc[4 * rg + 2] * sc[2], acc[4 * rg + 3] * sc[3]);
                    *(u32x2*)(mixed + tok * D + DRNN + 64 * g + j0) = o;
                }
            }
        }
        if (sub & 4) {
            float ga = 1.f, gh = 0.f;
            if (gi != 15) lookback16(agc + (size_t)gbase * DRNN, gi, la, lh);
            lookback16(AGG2 + (size_t)((ch / (SEQ / 64)) * 8) * DRNN + lane + 64 * w, grp, ga, gh);
            const float carry = la * gh + lh;
            const float carry0 = __shfl(carry, l31), carry1 = __shfl(carry, 32 + l31);
            LAS f16* stg = (LAS f16*)(F.lds + P2_STG_OFF + w * 4096);
#pragma unroll 1
            for (int it = 0; it < 4; ++it) {
                const int cb = it >> 1, tb = it & 1;
                const float cy = cb ? carry1 : carry0;
#pragma unroll
                for (int q = 0; q < 8; ++q) {
                    const f16x2 h2 = __builtin_bit_cast(f16x2, sth_[3][q]), p2 = __builtin_bit_cast(f16x2, stp_[3][q]);
                    const int r0 = 2 * q, r1 = 2 * q + 1;
                    stg[(4 * hi + (r0 & 3) + 8 * (r0 >> 2)) * 32 + l31] = (f16)((float)h2[0] + (float)p2[0] * cy);
                    stg[(4 * hi + (r1 & 3) + 8 * (r1 >> 2)) * 32 + l31] = (f16)((float)h2[1] + (float)p2[1] * cy);
                }
#pragma unroll
                for (int q = 0; q < 8; ++q) { sth_[3][q] = sth_[2][q]; sth_[2][q] = sth_[1][q]; sth_[1][q] = sth_[0][q]; stp_[3][q] = stp_[2][q]; stp_[2][q] = stp_[1][q]; stp_[1][q] = stp_[0][q]; }
                const int tk = lane >> 1, sg2 = lane & 1;
                const u32x4 h0 = *(const LAS u32x4*)(stg + tk * 32 + 8 * sg2), h1 = *(const LAS u32x4*)(stg + tk * 32 + 16 + 8 * sg2);
                const size_t go = (size_t)(tok0 + 32 * tb + tk) * D + 64 * w + 32 * cb + 8 * sg2;
                *(u32x4*)(mixed + go) = h0; *(u32x4*)(mixed + go + 16) = h1;
            }
        }
        if (sub & 16) {
            __syncthreads();
            {
                const char* ksrc = (const char*)(Kh + (size_t)b * NMEM * DX);
#pragma unroll
                for (int j = 0; j < 16; ++j) {
                    const int Pq = tid + 512 * j, key = Pq >> 5, pr = Pq & 31, hd = pr >> 3, chn = pr & 7;
                    const u32x4 v = *(const u32x4*)(ksrc + (size_t)Pq * 16);
                    *(LAS u32x4*)(F.lds + hd * 32768 + key * 128 + ((chn ^ (key & 7)) << 4)) = v;
                }
            }
            const int h = w >> 1, th = w & 1;
            const char* qb = (const char*)(proj + (size_t)(tok0 + 32 * th) * DIN + 2 * DRNN + DPOOL + 64 * h);
            const unsigned qoff = (unsigned)(l31 * DIN + 8 * hi) * 2u;
            f16x8 Qf[4];
#pragma unroll
            for (int s = 0; s < 4; ++s) Qf[s] = *(const f16x8*)(qb + 32 * s + (size_t)qoff);
            const char* vbase = (const char*)(VT + (size_t)b * DX * NMEM + (size_t)(64 * h) * NMEM);
            const unsigned voff = (unsigned)(l31 * NMEM + 8 * hi) * 2u;
            const float scl = 0.125f * LOG2E;
            __syncthreads();
            const LAS unsigned char* kl = F.lds + h * 32768 + l31 * 128;
            const int ksw = l31 & 7;
            float m = -INFINITY;
#pragma unroll 2
            for (int kb = 0; kb < 8; ++kb) {
                f32x16 acc;
#pragma unroll
                for (int r = 0; r < 16; ++r) acc[r] = 0.f;
#pragma unroll
                for (int s = 0; s < 4; ++s) { const f16x8 kfr = *(const LAS f16x8*)(kl + kb * 4096 + (((2 * s + hi) ^ ksw) << 4)); acc = __builtin_amdgcn_mfma_f32_32x32x16_f16(kfr, Qf[s], acc, 0, 0, 0); }
#pragma unroll
                for (int r = 0; r < 16; ++r) m = fmaxf(m, acc[r]);
            }
            m = fmaxf(m, __shfl_xor(m, 32));
            float sum = 0.f;
            f32x16 O[2];
#pragma unroll
            for (int db = 0; db < 2; ++db)
#pragma unroll
                for (int r = 0; r < 16; ++r) O[db][r] = 0.f;
            u32x4 va[2][2], vb2[2][2];
#define LOADV(dst, kb_) do { _Pragma("unroll") for (int s2 = 0; s2 < 2; ++s2) _Pragma("unroll") for (int db = 0; db < 2; ++db) { \
                const char* vp = vbase + (32 * db * NMEM + 32 * (kb_) + 16 * s2) * 2 + (size_t)voff; dst[s2][db] = *(const u32x4*)vp; } } while (0)
            LOADV(va, 0); LOADV(vb2, 1);
#pragma unroll 1
            for (int kb = 0; kb < 8; kb += 2) {
#pragma unroll
                for (int half2 = 0; half2 < 2; ++half2) {
                    const int kbb = kb + half2;
                    f32x16 acc;
#pragma unroll
                    for (int r = 0; r < 16; ++r) acc[r] = 0.f;
#pragma unroll
                    for (int s = 0; s < 4; ++s) { const f16x8 kfr = *(const LAS f16x8*)(kl + kbb * 4096 + (((2 * s + hi) ^ ksw) << 4)); acc = __builtin_amdgcn_mfma_f32_32x32x16_f16(kfr, Qf[s], acc, 0, 0, 0); }
#pragma unroll
                    for (int s2 = 0; s2 < 2; ++s2) {
                        f16x8 pf;
#pragma unroll
                        for (int j = 0; j < 8; ++j) { const float p = __builtin_amdgcn_exp2f((acc[8 * s2 + j] - m) * scl); sum += p; pf[j] = (f16)p; }
#pragma unroll
                        for (int db = 0; db < 2; ++db) {
                            const u32x4 vr = half2 ? vb2[s2][db] : va[s2][db];
                            const auto s0_ = __builtin_amdgcn_permlane32_swap(vr.x, vr.z, false, false), s1_ = __builtin_amdgcn_permlane32_swap(vr.y, vr.w, false, false);
                            u32x4 vq; vq.x = s0_[0]; vq.y = s1_[0]; vq.z = s0_[1]; vq.w = s1_[1];
                            const f16x8 vf = __builtin_bit_cast(f16x8, vq);
                            O[db] = __builtin_amdgcn_mfma_f32_32x32x16_f16(vf, pf, O[db], 0, 0, 0);
                        }
                    }
                    if (half2 == 0) { const int kn = (kb + 2 < 8) ? kb + 2 : 7; LOADV(va, kn); } else { const int kn = (kb + 3 < 8) ? kb + 3 : 7; LOADV(vb2, kn); }
                }
            }
#undef LOADV
            sum += __shfl_xor(sum, 32);
            const float inv = 1.f / sum;
            f16* orow = mixed + (size_t)(tok0 + 32 * th + l31) * D + DRNN + DPOOL + 64 * h + 4 * hi;
#pragma unroll
            for (int db = 0; db < 2; ++db)
#pragma unroll
                for (int rg = 0; rg < 4; ++rg) { u32x2 o; o.x = pk_f16(O[db][4 * rg] * inv, O[db][4 * rg + 1] * inv); o.y = pk_f16(O[db][4 * rg + 2] * inv, O[db][4 * rg + 3] * inv); *(u32x2*)(orow + 32 * db + 8 * rg) = o; }
        }
        asm volatile("s_waitcnt vmcnt(0)" ::: "memory");
        __syncthreads();
    }
}

__device__ __forceinline__ void p5_route(Frame& F) {
    const float* PARTL = (const float*)(F.ws + WS_PARTL); const float* SSQP = (const float*)(F.ws + WS_SSQP); const float* b_r = F.in[18];
    int* list = (int*)(F.ws + WS_LIST); float* glist = (float*)(F.ws + WS_GLIST); float* rlist = (float*)(F.ws + WS_RLIST);
    LAS float* lg = (LAS float*)(F.lds);
    LAS float* rs = (LAS float*)(F.lds + 8448);
    LAS int* sel_e = (LAS int*)(F.lds + 8704);
    LAS int* sel_r = (LAS int*)(F.lds + 9728);
    LAS float* sel_g = (LAS float*)(F.lds + 10752);
    LAS int* lcnt = (LAS int*)(F.lds + 11776);
    LAS int* lbase = (LAS int*)(F.lds + 11904);
    const int w = F.wave, lane = F.lane;
    for (int ch = F.bx; ch < T / 64; ch += F.G) {
        const int tok0 = ch * 64;
        if (F.tid < 32) lcnt[F.tid] = 0;
        {
            const int token = F.tid >> 3, e4 = (F.tid & 7) * 4;
            f32x4 sum = *(const f32x4*)(PARTL + (size_t)(tok0 + token) * 32 + e4); float ss = SSQP[tok0 + token];
#pragma unroll
            for (int pn = 1; pn < 4; ++pn) { sum += *(const f32x4*)(PARTL + ((size_t)pn * T + tok0 + token) * 32 + e4); ss += SSQP[(size_t)pn * T + tok0 + token]; }
            const float rstd = rsqrtf(ss * (1.f / D) + EPS);
            const f32x4 bb = *(const f32x4*)(b_r + e4);
#pragma unroll
            for (int j = 0; j < 4; ++j) lg[token * 33 + e4 + j] = sum[j] * (rstd * (1.f / 1024.f)) + bb[j];
            if ((F.tid & 7) == 0) rs[token] = rstd;
        }
        __syncthreads();
#pragma unroll 1
        for (int p = 0; p < 4; ++p) {
            const int token = 16 * p + 2 * w + (lane >> 5), le = lane & 31;
            float v = lg[token * 33 + le];
            int idx[4]; float val[4];
#pragma unroll
            for (int k = 0; k < 4; ++k) {
                float mx = v;
#pragma unroll
                for (int o = 1; o < 32; o <<= 1) mx = fmaxf(mx, __shfl_xor(mx, o));
                const unsigned long long bal = __ballot(v == mx);
                const unsigned half = (unsigned)(bal >> (lane & 32));
                const int bi = __builtin_ctz(half);
                idx[k] = bi; val[k] = mx;
                if (le == bi) v = -INFINITY;
            }
            if (le == 0) {
                float es[4], sum = 0.f;
#pragma unroll
                for (int k = 0; k < 4; ++k) { es[k] = __expf(val[k] - val[0]); sum += es[k]; }
                const float inv = 1.f / sum;
#pragma unroll
                for (int k = 0; k < 4; ++k) { const int sl = token * 4 + k; sel_e[sl] = idx[k]; sel_g[sl] = es[k] * inv; sel_r[sl] = atomicAdd((int*)&lcnt[idx[k]], 1); }
            }
        }
        __syncthreads();
        if (F.tid < 32) { const int n = lcnt[F.tid]; lbase[F.tid] = n ? (int)atomicAdd(&F.ctl[CW_COUNTS + 64 * F.tid], (unsigned)n) : 0; }
        __syncthreads();
        if (F.tid < 256) { const int e = sel_e[F.tid]; const int li = e * T + lbase[e] + sel_r[F.tid]; list[li] = (tok0 + (F.tid >> 2)) * 4 + (F.tid & 3); glist[li] = sel_g[F.tid]; rlist[li] = rs[F.tid >> 2]; }
        __syncthreads();
    }
}

__device__ __forceinline__ void p8_final(Frame& F) {
    const f16* x1 = (const f16*)(F.ws + WS_X1); const unsigned char* Y = F.ws + WS_Y; const float* g = F.in[23];
    float* out = (float*)F.out;
    const int gw = F.vcu * NWAVES + F.wave, NGW = F.G * NWAVES, lane = F.lane;
    const int per = (T + NGW - 1) / NGW;
    f32x4 gg[4];
#pragma unroll
    for (int j = 0; j < 4; ++j) gg[j] = ((const f32x4*)g)[lane + 64 * j];
    for (int t0 = gw * per; t0 < (gw + 1) * per && t0 < T; t0 += 4) {
        f16x4 xh[4][4]; int yv[4][4][4];
#pragma unroll
        for (int q = 0; q < 4; ++q) {
            const int tok = (t0 + q < T) ? t0 + q : T - 1;
#pragma unroll
            for (int j = 0; j < 4; ++j) {
                xh[q][j] = ((const f16x4*)(x1 + (size_t)tok * D))[lane + 64 * j];
#pragma unroll
                for (int k = 0; k < 4; ++k) yv[q][j][k] = __builtin_nontemporal_load((const int*)(Y + (size_t)(tok * 4 + k) * D + 4 * (lane + 64 * j)));
            }
        }
#pragma unroll
        for (int q = 0; q < 4; ++q) {
            f32x4 v[4]; float s = 0.f;
#pragma unroll
            for (int j = 0; j < 4; ++j) {
                f32x4 a = {(float)xh[q][j][0], (float)xh[q][j][1], (float)xh[q][j][2], (float)xh[q][j][3]};
#pragma unroll
                for (int k = 0; k < 4; ++k) { const f32x2 lo = __builtin_amdgcn_cvt_pk_f32_fp8(yv[q][j][k], false), hi2 = __builtin_amdgcn_cvt_pk_f32_fp8(yv[q][j][k], true);
                    a[0] += lo[0] * (1.f / SC_Y); a[1] += lo[1] * (1.f / SC_Y); a[2] += hi2[0] * (1.f / SC_Y); a[3] += hi2[1] * (1.f / SC_Y); }
                v[j] = a; s += (a[0] * a[0] + a[1] * a[1]) + (a[2] * a[2] + a[3] * a[3]);
            }
            s = wave_sum(s);
            const float r = rsqrtf(s * (1.f / D) + EPS);
            if (t0 + q < T && t0 + q < (gw + 1) * per) {
#pragma unroll
                for (int j = 0; j < 4; ++j) __builtin_nontemporal_store(v[j] * r * gg[j], (f32x4*)(out + (size_t)(t0 + q) * D) + lane + 64 * j);
            }
        }
    }
}

constexpr int NPHASE = 9;
__global__ void __launch_bounds__(NWAVES * 64, 2) mega(Params P) {
    extern __shared__ __attribute__((aligned(16))) unsigned char lds_raw[];
    Frame F;
    F.lds = (LAS unsigned char*)lds_raw;
    F.tid = threadIdx.x; F.lane = F.tid & 63; F.wave = __builtin_amdgcn_readfirstlane(F.tid >> 6);
    F.G = gridDim.x; F.bx = blockIdx.x; F.vcu = (F.G % 8 == 0) ? (F.bx % 8) * (F.G / 8) + F.bx / 8 : F.bx;
    F.ws = P.ws; F.ctl = (unsigned*)(P.ws + WS_CTL); F.in = P.in; F.out = P.out; F.flags = P.flags;
    for (int u = F.tid; u < (LDS_BYTES - LDS_CTL_OFF) / 4; u += NWAVES * 64) ((LAS unsigned*)(F.lds + LDS_CTL_OFF))[u] = 0u;
    __syncthreads();
    const int lo = P.ph_lo, hi = P.ph_hi;
    XcdBarrier bar; bar.bar = F.ctl + CW_BAR; bar.x = 0; bar.st = nullptr;
    if (hi - lo > 1) bar = xcd_barrier_post(F.ctl + CW_BAR, (volatile LAS unsigned*)(F.lds + LDS_CTL_OFF + 32));
#define IN(k) (lo <= (k) && (k) < hi)
#define SEAM(k) do { if (IN(k) && IN((k) + 1)) xcd_barrier(bar); } while (0)
    if (IN(0)) { p0_prologue(F); p0_small(F); SEAM(0); }
    if (IN(1)) {
        SchedP1 S{(const char*)(F.ws + WS_H0), (const char*)(F.ws + WS_WINT), (const char*)(F.ws + WS_MEMN), (const char*)(F.ws + WS_WKVT), F.G, F.bx};
        EpiP1 E{(f16*)(F.ws + WS_PROJ), (f16*)(F.ws + WS_KH), (f16*)(F.ws + WS_VT)};
        pg::gemm_phase(F.lds, S, E);
        p1_deferred_items(F);
        SEAM(1);
    }
    if (IN(2)) { p2_mixer(F); if (!IN(3)) {} }
    if (IN(3)) { SEAM(3); }
    if (IN(4)) {
        EpiP3 E{F.in[0], (f16*)(F.ws + WS_X1), F.ws + WS_X1N, F.in[16], (const f16*)(F.ws + WS_SMALLW + SW_WRP), (float*)(F.ws + WS_PARTL), (float*)(F.ws + WS_SSQP), F.lds};
        for (int L = F.bx; L < 64 * 4; L += F.G) { SchedP3 S{(const char*)(F.ws + WS_MIXED), (const char*)(F.ws + WS_WOUTT), L}; pg::gemm_phase(F.lds, S, E); }
        SEAM(4);
    }
    if (IN(5)) { p5_route(F); SEAM(5); }
    if (IN(6)) {
        moe_table(F);
        SchedMoe<8, true> S{(const char*)(F.ws + WS_X1N), (const char*)(F.ws + WS_WGUT), (size_t)2 * DFF * pg::ROWB8, (const int*)(F.ws + WS_LIST), (const LAS int*)(F.lds + LDS_CTL_OFF + 256), F.G, F.bx};
        EpiGU E{F.in[20], (const float*)(F.ws + WS_RLIST), (unsigned char*)(F.ws + WS_HBUF), F.flags & 1};
        pg::gemm_phase(F.lds, S, E);
        SEAM(6);
    }
    if (IN(7)) {
        moe_table(F);
        SchedMoe<4, false> S{(const char*)(F.ws + WS_HBUF), (const char*)(F.ws + WS_WDT), (size_t)D * pg::ROWB8, (const int*)(F.ws + WS_LIST), (const LAS int*)(F.lds + LDS_CTL_OFF + 256), F.G, F.bx};
        EpiDown E{F.in[22], (const int*)(F.ws + WS_LIST), (const float*)(F.ws + WS_GLIST), (unsigned char*)(F.ws + WS_Y), F.flags & 1};
        pg::gemm_phase(F.lds, S, E);
        SEAM(7);
    }
    if (IN(8)) { p8_final(F); }
#undef IN
#undef SEAM
}
}

extern "C" void kernel_launch(void* const* d_in, const int* in_sizes, int n_in, void* d_out, int out_size, void* d_ws, size_t ws_size, hipStream_t stream) {
    static int grid = 0;
    if (grid == 0) {
        if (n_in != 24 || ws_size < WS_END) { fprintf(stderr, "kernel_launch: unexpected n_in %d / ws %zu\n", n_in, ws_size); grid = -1; return; }
        int dev = 0, cus = 0;
        (void)hipGetDevice(&dev); (void)hipDeviceGetAttribute(&cus, hipDeviceAttributeMultiprocessorCount, dev);
        if (hipFuncSetAttribute((const void*)mega, hipFuncAttributeMaxDynamicSharedMemorySize, LDS_BYTES) != hipSuccess) { fprintf(stderr, "kernel_launch: hipFuncSetAttribute failed\n"); grid = -1; return; }
        int per_cu = 0;
        if (hipOccupancyMaxActiveBlocksPerMultiprocessor(&per_cu, (const void*)mega, NWAVES * 64, LDS_BYTES) != hipSuccess || per_cu < 1) fprintf(stderr, "kernel_launch: occupancy query says %d\n", per_cu);
        (void)hipGetLastError();
        grid = cus;
        if (grid % 8 != 0) fprintf(stderr, "kernel_launch: grid %d not a multiple of 8\n", grid);
    }
    if (grid < 0) return;
    unsigned char* ws = (unsigned char*)d_ws;
    (void)hipMemsetAsync(ws + WS_CTL, 0, 32768, stream);
    Params p{};
    for (int i = 0; i < 24; ++i) p.in[i] = (const float*)d_in[i];
    p.out = (float*)d_out; p.ws = ws;
    p.ph_lo = 0; p.ph_hi = NPHASE;
    hipLaunchKernelGGL(mega, dim3(grid), dim3(NWAVES * 64), LDS_BYTES, stream, p);
}
```

```cpp
#include <hip/hip_runtime.h>
#include <cstdio>
#include <cstdint>


namespace {
constexpr int BATCH = 2, SEQ = 8192, D = 1024, T = BATCH * SEQ, NMEM = 256;
constexpr int DRNN = 512, NH = 8, DPOOL = 256, DX = 256, XH = 4, DIN = 1536;
constexpr int NE = 32, TOPK = 4, DFF = 1024, TK = T * TOPK;
constexpr float EPS = 1e-6f;
typedef _Float16 f16;
typedef _Float16 f16x2 __attribute__((ext_vector_type(2)));
typedef _Float16 f16x4 __attribute__((ext_vector_type(4)));
typedef _Float16 f16x8 __attribute__((ext_vector_type(8)));
typedef float f32x2 __attribute__((ext_vector_type(2)));
typedef float f32x4 __attribute__((ext_vector_type(4)));
typedef unsigned u32x4 __attribute__((ext_vector_type(4)));
typedef unsigned u32x2 __attribute__((ext_vector_type(2)));
#define LAS __attribute__((address_space(3)))

constexpr size_t MiB = 1u << 20;
constexpr size_t WS_CTL = 0;
constexpr size_t WS_LIST = 1 * MiB;
constexpr size_t WS_TOPE = 3 * MiB;
constexpr size_t WS_TOPG = 3 * MiB + 512 * 1024;
constexpr size_t WS_SMALLW = 4 * MiB;
constexpr size_t WS_WKVT = 5 * MiB;
constexpr size_t WS_MEMN = 6 * MiB;
constexpr size_t WS_KH = 7 * MiB;
constexpr size_t WS_VT = 7 * MiB + 512 * 1024;
constexpr size_t WS_WINT = 8 * MiB;
constexpr size_t WS_WOUTT = 11 * MiB;
constexpr size_t WS_AGG = 13 * MiB;
constexpr size_t WS_KVF = 14 * MiB;
constexpr size_t WS_GLIST = 14 * MiB;
constexpr size_t WS_WGUT = 16 * MiB;
constexpr size_t WS_WDT = 144 * MiB;
constexpr size_t WS_H0 = 208 * MiB;
constexpr size_t WS_PROJ = 240 * MiB;
constexpr size_t WS_PARTL = 288 * MiB;
constexpr size_t WS_SSQP = 296 * MiB;
constexpr size_t WS_RLIST = 297 * MiB;
constexpr size_t WS_MIXED = 352 * MiB;
constexpr size_t WS_X1 = 384 * MiB;
constexpr size_t WS_X1N = 448 * MiB;
constexpr size_t WS_HBUF = 482 * MiB;
constexpr size_t WS_Y = 626 * MiB;
constexpr size_t WS_END = 756 * MiB;
constexpr int CW_COUNTS = 0;
constexpr int CW_BAR = 4096;

struct Params {
    const float* in[24];
    float* out;
    unsigned char* ws;
    int ph_lo, ph_hi, flags, pad;
};

__device__ __forceinline__ float wave_sum(float v) {
#pragma unroll
    for (int o = 1; o < 64; o <<= 1) v += __shfl_xor(v, o);
    return v;
}
__device__ __forceinline__ float sigmoidf_(float x) { return 1.f / (1.f + expf(-x)); }
__device__ __forceinline__ unsigned pk_f16(float lo, float hi) { f32x2 v = {lo, hi}; f16x2 h = __builtin_convertvector(v, f16x2); return __builtin_bit_cast(unsigned, h); }
constexpr float SC_W = 64.f, SC_X = 16.f, SC_H = 4.f, SC_Y = 16.f;
__device__ __forceinline__ unsigned pk4_fp8(float a, float b, float c, float d) { int r = __builtin_amdgcn_cvt_pk_fp8_f32(a, b, 0, false); r = __builtin_amdgcn_cvt_pk_fp8_f32(c, d, r, true); return (unsigned)r; }
__device__ __forceinline__ float4 load4(const float* p) { return *(const float4*)p; }
__device__ __forceinline__ float4 load4(const f16* p) { const f16x4 h = *(const f16x4*)p; return make_float4((float)h[0], (float)h[1], (float)h[2], (float)h[3]); }
__device__ __forceinline__ void store4(float* p, float4 v) { *(float4*)p = v; }
__device__ __forceinline__ void store4(f16* p, float4 v) { u32x2 w; w.x = pk_f16(v.x, v.y); w.y = pk_f16(v.z, v.w); *(u32x2*)p = w; }
__device__ __forceinline__ int gu_dest_row(int n) { return n < DFF ? ((n >> 7) * 256 + (n & 127)) : (((n - DFF) >> 7) * 256 + 128 + ((n - DFF) & 127)); }

namespace pg {
constexpr int LDS_EPI = 139264 + 8192;
constexpr int LDS_PF_OFF = 139264 + 4096;
constexpr int BM = 256, BK = 64, HALF = 128, HTB = HALF * BK * 2, STAGE_BYTES = 8 * HTB, KD = 1024, NT = KD / BK;
constexpr unsigned ROWB = KD * 2;
constexpr unsigned ROWB8 = KD;
typedef int i32x8 __attribute__((ext_vector_type(8)));
__host__ __device__ __forceinline__ int lds_byte(int r, int c) { const int st = (r >> 4) * 2 + (c >> 5), rr = r & 15, cc = c & 31, ob = rr * 64 + cc * 2; return st * 1024 + (ob ^ (((ob >> 9) & 1) << 5)); }
__host__ __device__ __forceinline__ void stage_rc(int b, int& R, int& C) { const int st = b / 1024, sb = b % 1024, swz = sb ^ (((sb >> 9) & 1) << 5); R = (st >> 1) * 16 + swz / 64; C = (st & 1) * 32 + (swz % 64) / 2; }
__host__ __device__ __forceinline__ int perm32(int rho) { const int n = rho >> 4, i = rho & 15; return 8 * (i >> 2) + 4 * n + (i & 3); }

struct Unit { const char* A; const char* B; int kind, pm, pn, e, p0, cnt, hrow; };

__device__ __forceinline__ void glds16(const void* sbase, unsigned voff, unsigned lds_dst) {
    unsigned keep;
    asm volatile("s_mov_b32 %0, m0\n\ts_mov_b32 m0, %3\n\ts_nop 0\n\tglobal_load_lds_dwordx4 %1, %2\n\ts_mov_b32 m0, %0"
                 : "=&s"(keep) : "v"(voff), "s"(sbase), "s"(lds_dst) : "memory");
}
__device__ __forceinline__ const char* uptr(const char* p) {
    const unsigned long long v = (unsigned long long)(size_t)p;
    const unsigned lo = __builtin_amdgcn_readfirstlane((unsigned)v), hi = __builtin_amdgcn_readfirstlane((unsigned)(v >> 32));
    return (const char*)(size_t)(((unsigned long long)hi << 32) | lo);
}
__device__ __forceinline__ void glds4_prefetch(const void* sbase, unsigned voff, unsigned lds_dst) {
    unsigned keep;
    asm volatile("s_nop 4\n\ts_mov_b32 %0, m0\n\ts_mov_b32 m0, %3\n\ts_nop 0\n\tglobal_load_lds_dword %1, %2\n\ts_mov_b32 m0, %0"
                 : "=&s"(keep) : "v"(voff), "s"(sbase), "s"(lds_dst) : "memory");
}
__device__ __forceinline__ void glds16n(const void* sbase, unsigned voff, unsigned lds_dst) {
    unsigned keep;
    asm volatile("s_nop 4\n\ts_mov_b32 %0, m0\n\ts_mov_b32 m0, %3\n\ts_nop 0\n\tglobal_load_lds_dwordx4 %1, %2\n\ts_mov_b32 m0, %0"
                 : "=&s"(keep) : "v"(voff), "s"(sbase), "s"(lds_dst) : "memory");
}
template <class Sched, class Epi>
__device__ __forceinline__ void gemm_phase(LAS unsigned char* lds, const Sched& S, const Epi& E) {
    constexpr bool FP8 = Epi::FP8, GATHER = Sched::GATHER;
    constexpr unsigned ROWB_ = FP8 ? ROWB8 : ROWB;
    constexpr int NT_ = FP8 ? (KD / 128) : (KD / BK);
    const int tid = threadIdx.x, wid = __builtin_amdgcn_readfirstlane(tid >> 6), lane = tid & 63, wr = wid >> 2, wc = wid & 3, fr = lane & 15, fq = lane >> 4;
    int R0, C0; stage_rc(tid * 16, R0, C0);
    const unsigned colb = (unsigned)C0 * 2u;
    const unsigned voffA0 = (unsigned)R0 * ROWB_ + colb;
    const unsigned voffB0 = (unsigned)(Epi::PERM ? ((R0 & ~31) + perm32(R0 & 31)) : R0) * ROWB_ + colb;
    unsigned arow[4], arowN[4];
    const size_t kstep = (size_t)(BK * 2);
    const size_t hstepB = (size_t)HALF * ROWB_, qstep = (size_t)64 * ROWB_;
    const unsigned ldsb = (unsigned)(size_t)lds + (unsigned)wid * 1024u;
    const int aoff = lds_byte(wr * 64 + fr, fq * 8), boff = lds_byte(wc * 32 + fr, fq * 8);
#define PG_SA(b, h) (((b) * 2 + (h)) * HTB)
#define PG_SB(b, h) ((4 + (b) * 2 + (h)) * HTB)
#define PG_STAGEB(bufoff, gbase) do { glds16((const char*)(gbase), voffB0, ldsb + (bufoff)); glds16((const char*)(gbase) + qstep, voffB0, ldsb + (bufoff) + 8192); } while (0)
#define PG_STAGEA(bufoff, gbase, r0_, r1_, h) do { \
        if constexpr (GATHER) { glds16((const char*)(gbase), (r0_), ldsb + (bufoff)); glds16((const char*)(gbase), (r1_), ldsb + (bufoff) + 8192); } \
        else { glds16((const char*)(gbase) + (2 * (h)) * qstep, voffA0, ldsb + (bufoff)); glds16((const char*)(gbase) + (2 * (h) + 1) * qstep, voffA0, ldsb + (bufoff) + 8192); } } while (0)
#define PG_LDA(dst, b, h) do { _Pragma("unroll") for (int m = 0; m < 4; ++m) { \
        if constexpr (FP8) { const u32x4 lo_ = *(const LAS u32x4*)(lds + PG_SA(b, h) + aoff + m * 2048), hi_ = *(const LAS u32x4*)(lds + PG_SA(b, h) + aoff + m * 2048 + 1024); dst##8[m] = __builtin_shufflevector(lo_, hi_, 0, 1, 2, 3, 4, 5, 6, 7); } \
        else { _Pragma("unroll") for (int k = 0; k < 2; ++k) dst[m][k] = *(const LAS f16x8*)(lds + PG_SA(b, h) + aoff + m * 2048 + k * 1024); } } } while (0)
#define PG_LDB(dst, b, h) do { _Pragma("unroll") for (int n = 0; n < 2; ++n) { \
        if constexpr (FP8) { const u32x4 lo_ = *(const LAS u32x4*)(lds + PG_SB(b, h) + boff + n * 2048), hi_ = *(const LAS u32x4*)(lds + PG_SB(b, h) + boff + n * 2048 + 1024); dst##8[n] = __builtin_shufflevector(lo_, hi_, 0, 1, 2, 3, 4, 5, 6, 7); } \
        else { _Pragma("unroll") for (int k = 0; k < 2; ++k) dst[n][k] = *(const LAS f16x8*)(lds + PG_SB(b, h) + boff + n * 2048 + k * 1024); } } } while (0)
#define PG_MMA(ai, bj, At, Bt) do { __builtin_amdgcn_s_setprio(1); _Pragma("unroll") for (int m = 0; m < 4; ++m) _Pragma("unroll") for (int n = 0; n < 2; ++n) { \
        if constexpr (FP8) asm volatile("v_mfma_scale_f32_16x16x128_f8f6f4 %0, %1, %2, %0, %3, %3 op_sel_hi:[0,0,0]" : "+v"(acc[ai][bj][m][n]) : "v"(Bt##8[n]), "v"(At##8[m]), "v"(mxscale)); \
        else { _Pragma("unroll") for (int k = 0; k < 2; ++k) acc[ai][bj][m][n] = __builtin_amdgcn_mfma_f32_16x16x32_f16(Bt[n][k], At[m][k], acc[ai][bj][m][n], 0, 0, 0); } } \
        __builtin_amdgcn_s_setprio(0); } while (0)
#define PG_WAIT_V(n) asm volatile("s_waitcnt vmcnt(" #n ")" ::: "memory")
#define PG_WAIT_L(n) asm volatile("s_waitcnt lgkmcnt(" #n ")" ::: "memory")
#define PG_BAR __builtin_amdgcn_s_barrier()
#define PG_SCHED __builtin_amdgcn_sched_barrier(0)
    Unit cur, nxt; int ui = 0;
    if (!S.next(0, cur)) return;
    if constexpr (GATHER) S.rows(cur, R0, colb, arow);
    f32x4 acc[2][2][4][2];
    f16x8 At[4][2], B0[2][2], B1[2][2];
    typedef unsigned u32x8 __attribute__((ext_vector_type(8)));
    u32x8 At8[4], B08[2], B18[2];
    unsigned mxscale = 0x7F7F7F7Fu; asm volatile("" : "+v"(mxscale));
    const char* cA = cur.A; const char* cB = cur.B;
    PG_WAIT_V(0);
    E.init(acc, cur, wr, wc, fr, fq);
    E.prefetch(cur, wid, lane, (unsigned)(size_t)lds + (unsigned)LDS_EPI);
    PG_STAGEB(PG_SB(0, 0), cB); PG_STAGEB(PG_SB(0, 1), cB + hstepB); PG_STAGEA(PG_SA(0, 0), cA, arow[0], arow[1], 0); PG_STAGEA(PG_SA(0, 1), cA, arow[2], arow[3], 1);
    if (wr == 1) PG_BAR;
    PG_WAIT_V(2); PG_BAR;
    PG_STAGEB(PG_SB(1, 0), cB + kstep); PG_STAGEA(PG_SA(1, 0), cA + kstep, arow[0], arow[1], 0); PG_STAGEB(PG_SB(1, 1), cB + hstepB + kstep);
    PG_WAIT_V(6); PG_BAR;
#pragma unroll
    for (int a = 0; a < 2; ++a)
#pragma unroll
        for (int b = 0; b < 2; ++b)
            asm volatile("" : "+v"(acc[a][b][0][0]), "+v"(acc[a][b][0][1]), "+v"(acc[a][b][1][0]), "+v"(acc[a][b][1][1]), "+v"(acc[a][b][2][0]), "+v"(acc[a][b][2][1]), "+v"(acc[a][b][3][0]), "+v"(acc[a][b][3][1]));
    for (;;) {
        const bool has_next = S.next(ui + 1, nxt);
        const char* nA = has_next ? nxt.A : cA; const char* nB = has_next ? nxt.B : cB;
        const int hf_ = Sched::HALVES ? __builtin_amdgcn_readfirstlane(cur.kind) : 0;
        unsigned rawN[4];
        if constexpr (GATHER) {
            if (has_next) S.rows_issue(nxt, R0, rawN);
            else {
#pragma unroll
                for (int q = 0; q < 4; ++q) arowN[q] = arow[q];
            }
        }
#pragma unroll 1
        for (int t = 0; t < NT_; t += 2) {
            const bool last = (t == NT_ - 2);
            if (t == 2 && has_next) E.prefetch(nxt, wid, lane, (unsigned)(size_t)lds + (unsigned)LDS_EPI + (unsigned)(((ui + 1) & 1) * 4096));
            if constexpr (GATHER) {
                if (last && has_next) {
                    asm volatile("s_waitcnt vmcnt(8)" : "+v"(rawN[0]), "+v"(rawN[1]), "+v"(rawN[2]), "+v"(rawN[3]) :: "memory");
                    S.rows_finish(nxt, R0, colb, rawN, arowN);
                }
            }
            const char* a1 = cA + (size_t)(t + 1) * kstep;
            const char* a2 = last ? nA : cA + (size_t)(t + 2) * kstep; const char* b2 = last ? nB : cB + (size_t)(t + 2) * kstep;
            const char* a3 = a2 + kstep; const char* b3 = b2 + kstep;
            PG_LDB(B0, 0, 0); PG_LDB(B1, 0, 1); PG_SCHED; PG_LDA(At, 0, 0); PG_STAGEA(PG_SA(1, 1), a1, arow[2], arow[3], 1);
            PG_WAIT_V(8); PG_WAIT_L(0); PG_BAR; if (!Sched::HALVES || hf_ != 2) { PG_MMA(0, 0, At, B0); PG_MMA(0, 1, At, B1); } PG_BAR; PG_SCHED;
            PG_LDA(At, 0, 1); PG_STAGEB(PG_SB(0, 0), b2); PG_STAGEB(PG_SB(0, 1), b2 + hstepB); PG_STAGEA(PG_SA(0, 0), a2, (last ? arowN[0] : arow[0]), (last ? arowN[1] : arow[1]), 0);
            PG_WAIT_V(8); PG_WAIT_L(0); PG_BAR; if (!Sched::HALVES || hf_ != 1) { PG_MMA(1, 0, At, B0); PG_MMA(1, 1, At, B1); } PG_BAR; PG_SCHED;
            PG_LDB(B0, 1, 0); PG_LDB(B1, 1, 1); PG_SCHED; PG_LDA(At, 1, 0); PG_STAGEA(PG_SA(0, 1), a2, (last ? arowN[2] : arow[2]), (last ? arowN[3] : arow[3]), 1);
            PG_WAIT_V(8); PG_WAIT_L(0); PG_BAR; if (!Sched::HALVES || hf_ != 2) { PG_MMA(0, 0, At, B0); PG_MMA(0, 1, At, B1); } PG_BAR; PG_SCHED;
            PG_LDA(At, 1, 1); PG_STAGEB(PG_SB(1, 0), b3); PG_STAGEB(PG_SB(1, 1), b3 + hstepB); PG_STAGEA(PG_SA(1, 0), a3, (last ? arowN[0] : arow[0]), (last ? arowN[1] : arow[1]), 0);
            PG_WAIT_V(8); PG_WAIT_L(0); PG_BAR; if (!Sched::HALVES || hf_ != 1) { PG_MMA(1, 0, At, B0); PG_MMA(1, 1, At, B1); } PG_BAR; PG_SCHED;
        }
        if constexpr (Sched::PREFETCH) {
            if (has_next) {
                const unsigned pf_lds = (unsigned)(size_t)lds + (unsigned)(LDS_PF_OFF) + (unsigned)wid * 256u;
                if constexpr (GATHER) { if ((wid & 1) == 0) { const unsigned q = (unsigned)lane & 3u; const unsigned ro = (q == 0 ? arowN[0] : q == 1 ? arowN[1] : q == 2 ? arowN[2] : arowN[3]) - colb; glds4_prefetch(uptr(nA + 128 * nxt.pn), ro, pf_lds); } }
                else { const unsigned t_ = (unsigned)tid & 255u, k_ = (unsigned)(2 * nxt.pn) + ((unsigned)tid >> 8); glds4_prefetch(uptr(nA), t_ * ROWB_ + 128u * k_, pf_lds); }
            }
        }
        if (wr == 0) PG_BAR;
        if constexpr (FP8) asm volatile("s_nop 15\n\ts_nop 15" ::: "memory");
        E(acc, cur, wr, wc, fr, fq, lds + LDS_EPI + (ui & 1) * 4096);
        if (!has_next) break;
        E.init(acc, nxt, wr, wc, fr, fq);
        cur = nxt; cA = nA; cB = nB; ++ui;
        if constexpr (GATHER) {
#pragma unroll
            for (int q = 0; q < 4; ++q) arow[q] = arowN[q];
        }
        if (wr == 1) PG_BAR;
    }
    PG_WAIT_V(0);
    PG_BAR;
#undef PG_SA
#undef PG_SB
#undef PG_STAGEA
#undef PG_STAGEB
#undef PG_LDA
#undef PG_LDB
#undef PG_MMA
#undef PG_WAIT_V
#undef PG_WAIT_L
#undef PG_BAR
#undef PG_SCHED
}

__device__ __forceinline__ void zero_acc(f32x4 (&acc)[2][2][4][2]) {
#pragma unroll
    for (int a = 0; a < 2; ++a)
#pragma unroll
        for (int b = 0; b < 2; ++b)
#pragma unroll
            for (int m = 0; m < 4; ++m)
#pragma unroll
                for (int n = 0; n < 2; ++n) acc[a][b][m][n] = (f32x4){0.f, 0.f, 0.f, 0.f};
}
template <unsigned RB = ROWB> __device__ __forceinline__ void dense_rows(int R0, unsigned colb, unsigned (&ar)[4]) {
#pragma unroll
    for (int q = 0; q < 4; ++q) ar[q] = (unsigned)(R0 + 64 * q) * RB + colb;
}
}

constexpr int NWAVES = 8;
constexpr int RING_BYTES = 131072;
constexpr int LDS_CTL_OFF = 139264;
constexpr int LDS_EPI_OFF = LDS_CTL_OFF + 8192;
constexpr int LDS_BYTES = 163840;

#define XB_TMO      128
#define XB_XCNT(j)  (256  + 64 * (j))
#define XB_XSUB(j)  (1280 + 64 * (j))
#define XB_XGEN(j)  (2304 + 64 * (j))
#define XB_TOP      3328
#define XB_TOPGEN   3392
#define XCD_BAR_WORDS 3456
#define XB_SPIN_CAP (1u << 18)
__device__ __forceinline__ unsigned xb_ld(unsigned* p)              { return __hip_atomic_load(p, __ATOMIC_RELAXED, __HIP_MEMORY_SCOPE_AGENT); }
__device__ __forceinline__ unsigned xb_add(unsigned* p, unsigned v) { return __hip_atomic_fetch_add(p, v, __ATOMIC_RELAXED, __HIP_MEMORY_SCOPE_AGENT); }
__device__ __forceinline__ unsigned xb_xcc_id() { return (unsigned)__builtin_amdgcn_s_getreg((3 << 11) | 20) & 0xFu; }
#define XB_SPIN(cond, bar) do { unsigned _sp = 0; while (cond) { __builtin_amdgcn_s_sleep(1); \
    if ((++_sp & 255u) == 0u) { if (xb_ld(&(bar)[XB_TMO])) break; if (_sp > XB_SPIN_CAP) { atomicAdd(&(bar)[XB_TMO], 1u); break; } } } } while (0)
struct XcdBarrier { unsigned* bar; unsigned x; volatile LAS unsigned* st; };
__device__ __forceinline__ XcdBarrier xcd_barrier_post(unsigned* bar, volatile LAS unsigned* st) {
    XcdBarrier b; b.bar = bar; b.x = xb_xcc_id(); b.st = st;
    if (threadIdx.x == 0) (void)xb_add(&bar[XB_XCNT(b.x)], 1u);
    return b;
}
__device__ __forceinline__ void xcd_barrier_complete(unsigned* bar, unsigned x, unsigned& nloc, unsigned& nx) {
    const unsigned G = gridDim.x * gridDim.y * gridDim.z;
    unsigned sum, cnt, mine, sp = 0u;
    for (;;) {
        sum = 0u; cnt = 0u; mine = 0u;
#pragma unroll
        for (unsigned j = 0; j < 16; ++j) { const unsigned c = xb_ld(&bar[XB_XCNT(j)]); sum += c; cnt += (c > 0u) ? 1u : 0u; mine = (j == x) ? c : mine; }
        if (sum == G) break;
        __builtin_amdgcn_s_sleep(1);
        if ((++sp & 255u) == 0u) { if (xb_ld(&bar[XB_TMO])) break; if (sp > XB_SPIN_CAP) { atomicAdd(&bar[XB_TMO], 1u); break; } }
    }
    nloc = mine > 0u ? mine : 1u; nx = cnt > 0u ? cnt : 1u;
}
__device__ __forceinline__ void xcd_barrier(const XcdBarrier& b) {
    asm volatile("s_waitcnt vmcnt(0)" ::: "memory");
    __syncthreads();
    if (threadIdx.x == 0) {
        unsigned* bar = b.bar;
        __builtin_amdgcn_s_waitcnt(0);
        unsigned nloc = b.st[0], nx = b.st[1];
        if (nloc == 0u) { xcd_barrier_complete(bar, b.x, nloc, nx); b.st[0] = nloc; b.st[1] = nx; }
        const unsigned old = xb_add(&bar[XB_XSUB(b.x)], 1u);
        const unsigned gen = old / nloc;
        if (old + 1u == (gen + 1u) * nloc) {
            __builtin_amdgcn_fence(__ATOMIC_RELEASE, "agent");
            asm volatile("s_waitcnt vmcnt(0)" ::: "memory");
            const unsigned og = xb_add(&bar[XB_TOP], 1u);
            const unsigned tg = og / nx;
            if (og + 1u == (tg + 1u) * nx) xb_add(&bar[XB_TOPGEN], 1u);
            else XB_SPIN(xb_ld(&bar[XB_TOPGEN]) == tg, bar);
            __builtin_amdgcn_fence(__ATOMIC_ACQUIRE, "agent");
            xb_add(&bar[XB_XGEN(b.x)], 1u);
            asm volatile("s_waitcnt vmcnt(0)" ::: "memory");
        } else {
            XB_SPIN(xb_ld(&bar[XB_XGEN(b.x)]) == gen, bar);
            __builtin_amdgcn_fence(__ATOMIC_ACQUIRE, "agent");
            asm volatile("s_waitcnt vmcnt(0)" ::: "memory");
        }
    }
    __syncthreads();
}

struct Frame {
    LAS unsigned char* lds;
    unsigned* ctl;
    unsigned char* ws;
    int tid, lane, wave, vcu, G, bx;
    const float* const* in;
    float* out;
    int flags;
};

__device__ __forceinline__ void p0_transpose_item(const float* __restrict__ src, int ld, int k0, int n0, f16* __restrict__ dst, int drow0, LAS unsigned* scr, int lane) {
    const int n4 = lane & 15, rr = lane >> 4;
    const float* s0 = src + (size_t)(k0 + 2 * rr) * ld + n0 + 4 * n4;
#pragma unroll 4
    for (int it = 0; it < 16; ++it) {
        const float4 v0 = *(const float4*)(s0 + (size_t)(8 * it) * ld);
        const float4 v1 = *(const float4*)(s0 + (size_t)(8 * it + 1) * ld);
        const int kp = it * 4 + rr;
        scr[(4 * n4 + 0) * 65 + kp] = pk_f16(v0.x, v1.x);
        scr[(4 * n4 + 1) * 65 + kp] = pk_f16(v0.y, v1.y);
        scr[(4 * n4 + 2) * 65 + kp] = pk_f16(v0.z, v1.z);
        scr[(4 * n4 + 3) * 65 + kp] = pk_f16(v0.w, v1.w);
    }
    asm volatile("s_waitcnt lgkmcnt(0)" ::: "memory");
    const int c = lane & 15, nl = lane >> 4;
#pragma unroll 4
    for (int jt = 0; jt < 16; ++jt) {
        const int n = jt * 4 + nl;
        u32x4 o; o.x = scr[n * 65 + 4 * c + 0]; o.y = scr[n * 65 + 4 * c + 1]; o.z = scr[n * 65 + 4 * c + 2]; o.w = scr[n * 65 + 4 * c + 3];
        *(u32x4*)(dst + (size_t)(drow0 + n) * 1024 + k0 + 8 * c) = o;
    }
    asm volatile("s_waitcnt lgkmcnt(0)" ::: "memory");
}
__device__ __forceinline__ void p0_transpose_item_fp8(const float* __restrict__ src, int ld, int k0, int n0, unsigned char* __restrict__ dst, int drow0, float sc, LAS unsigned* scr, int lane) {
    const int n4 = lane & 15, rr = lane >> 4;
    const float* s0 = src + (size_t)(k0 + 4 * rr) * ld + n0 + 4 * n4;
#pragma unroll 4
    for (int it = 0; it < 16; ++it) {
        const float* sp = s0 + (size_t)(16 * it) * ld;
        typedef float f4nt __attribute__((ext_vector_type(4)));
        const f4nt n0_ = __builtin_nontemporal_load((const f4nt*)(sp)), n1_ = __builtin_nontemporal_load((const f4nt*)(sp + ld)), n2_ = __builtin_nontemporal_load((const f4nt*)(sp + 2 * (size_t)ld)), n3_ = __builtin_nontemporal_load((const f4nt*)(sp + 3 * (size_t)ld));
        const float4 v0 = {n0_[0], n0_[1], n0_[2], n0_[3]}, v1 = {n1_[0], n1_[1], n1_[2], n1_[3]}, v2 = {n2_[0], n2_[1], n2_[2], n2_[3]}, v3 = {n3_[0], n3_[1], n3_[2], n3_[3]};
        const int kq = it * 4 + rr;
        scr[(4 * n4 + 0) * 65 + kq] = pk4_fp8(v0.x * sc, v1.x * sc, v2.x * sc, v3.x * sc);
        scr[(4 * n4 + 1) * 65 + kq] = pk4_fp8(v0.y * sc, v1.y * sc, v2.y * sc, v3.y * sc);
        scr[(4 * n4 + 2) * 65 + kq] = pk4_fp8(v0.z * sc, v1.z * sc, v2.z * sc, v3.z * sc);
        scr[(4 * n4 + 3) * 65 + kq] = pk4_fp8(v0.w * sc, v1.w * sc, v2.w * sc, v3.w * sc);
    }
    asm volatile("s_waitcnt lgkmcnt(0)" ::: "memory");
    const int c = lane & 15, nl = lane >> 4;
#pragma unroll 4
    for (int jt = 0; jt < 16; ++jt) {
        const int n = jt * 4 + nl;
        u32x4 o; o.x = scr[n * 65 + 4 * c + 0]; o.y = scr[n * 65 + 4 * c + 1]; o.z = scr[n * 65 + 4 * c + 2]; o.w = scr[n * 65 + 4 * c + 3];
        __builtin_nontemporal_store(o, (u32x4*)(dst + (size_t)(drow0 + n) * 1024 + k0 + 16 * c));
    }
    asm volatile("s_waitcnt lgkmcnt(0)" ::: "memory");
}
__device__ __forceinline__ void rms_row_f16(const float* __restrict__ xrow, const float* __restrict__ g, f16* __restrict__ orow, int lane) {
    const f32x4* xr = (const f32x4*)xrow + lane;
    f32x4 v[4]; float s = 0.f;
#pragma unroll
    for (int j = 0; j < 4; ++j) { v[j] = __builtin_nontemporal_load(xr + 64 * j); s += (v[j].x * v[j].x + v[j].y * v[j].y) + (v[j].z * v[j].z + v[j].w * v[j].w); }
    const float rstd = rsqrtf(wave_sum(s) * (1.f / D) + EPS);
    u32x2* o8 = (u32x2*)orow + lane;
#pragma unroll
    for (int j = 0; j < 4; ++j) { const f32x4 gg = ((const f32x4*)g)[lane + 64 * j]; u32x2 w; w.x = pk_f16(v[j].x * rstd * gg.x, v[j].y * rstd * gg.y); w.y = pk_f16(v[j].z * rstd * gg.z, v[j].w * rstd * gg.w); o8[64 * j] = w; }
}
constexpr int P0_IGU = NE * 4 * (2 * DFF / 64), P0_IDN = NE * 4 * (D / 64), P0_IEXP = P0_IGU + P0_IDN;
constexpr int P1_NGEMM = 192;
constexpr int P1_IDLE0 = P1_NGEMM + 4;
constexpr int P1_ITEMS_PER_WAVE = 2;
constexpr int P0_DEFER = (256 - P1_IDLE0) * 8 * P1_ITEMS_PER_WAVE;
__device__ __forceinline__ void p0_expert_item(Frame& F, int r, LAS unsigned* scr) {
    const float* w_gu = F.in[19]; const float* w_down = F.in[21];
    unsigned char* WguT = F.ws + WS_WGUT; unsigned char* WdT = F.ws + WS_WDT;
    if (r < P0_IGU) { const int e = r / (4 * 32), q = r % (4 * 32), nb = q & 31, kb = q >> 5;
        p0_transpose_item_fp8(w_gu + (size_t)e * D * 2 * DFF, 2 * DFF, kb * 256, nb * 64, WguT + (size_t)e * 2 * DFF * 1024, gu_dest_row(nb * 64), SC_W, scr, F.lane); }
    else { r -= P0_IGU; const int e = r / (4 * 16), q = r % (4 * 16), nb = q & 15, kb = q >> 4; p0_transpose_item_fp8(w_down + (size_t)e * DFF * D, D, kb * 256, nb * 64, WdT + (size_t)e * D * 1024, nb * 64, SC_W, scr, F.lane); }
}
typedef float f4nt __attribute__((ext_vector_type(4)));
struct ExpItem { const float* s0; size_t ld; unsigned char* dst; };
__device__ __forceinline__ ExpItem exp_item(Frame& F, int r) {
    const float* w_gu = F.in[19]; const float* w_down = F.in[21];
    const int n4 = F.lane & 15, rr = F.lane >> 4;
    ExpItem I;
    if (r < P0_IGU) { const int e = r / (4 * 32), q = r % (4 * 32), nb = q & 31, kb = q >> 5;
        I.ld = 2 * DFF; I.s0 = w_gu + (size_t)e * D * 2 * DFF + (size_t)(kb * 256 + 4 * rr) * (2 * DFF) + nb * 64 + 4 * n4; I.dst = F.ws + WS_WGUT + (size_t)e * 2 * DFF * 1024 + (size_t)gu_dest_row(nb * 64) * 1024 + kb * 256; }
    else { r -= P0_IGU; const int e = r / (4 * 16), q = r % (4 * 16), nb = q & 15, kb = q >> 4;
        I.ld = D; I.s0 = w_down + (size_t)e * DFF * D + (size_t)(kb * 256 + 4 * rr) * D + nb * 64 + 4 * n4; I.dst = F.ws + WS_WDT + (size_t)e * D * 1024 + (size_t)(nb * 64) * 1024 + kb * 256; }
    return I;
}
__device__ __forceinline__ void exp_issue(const ExpItem& I, int b, f4nt (&buf)[16]) {
#pragma unroll
    for (int i = 0; i < 4; ++i) { const float* sp = I.s0 + (size_t)(16 * (4 * b + i)) * I.ld;
#pragma unroll
        for (int j = 0; j < 4; ++j) buf[4 * i + j] = __builtin_nontemporal_load((const f4nt*)(sp + j * I.ld)); }
}
__device__ __forceinline__ void exp_consume(const f4nt (&buf)[16], int b, LAS unsigned* scr, int lane) {
    const int n4 = lane & 15, rr = lane >> 4;
#pragma unroll
    for (int i = 0; i < 4; ++i) { const int kq = (4 * b + i) * 4 + rr;
#pragma unroll
        for (int c = 0; c < 4; ++c) scr[(4 * n4 + c) * 65 + kq] = pk4_fp8(buf[4 * i][c] * SC_W, buf[4 * i + 1][c] * SC_W, buf[4 * i + 2][c] * SC_W, buf[4 * i + 3][c] * SC_W); }
}
__device__ __forceinline__ void exp_flush(const ExpItem& I, LAS unsigned* scr, int lane) {
    asm volatile("s_waitcnt lgkmcnt(0)" ::: "memory");
    const int c = lane & 15, nl = lane >> 4;
#pragma unroll 4
    for (int jt = 0; jt < 16; ++jt) {
        const int n = jt * 4 + nl;
        u32x4 o; o.x = scr[n * 65 + 4 * c + 0]; o.y = scr[n * 65 + 4 * c + 1]; o.z = scr[n * 65 + 4 * c + 2]; o.w = scr[n * 65 + 4 * c + 3];
        __builtin_nontemporal_store(o, (u32x4*)(I.dst + (size_t)n * 1024 + 16 * c));
    }
    asm volatile("s_waitcnt lgkmcnt(0)" ::: "memory");
}
__device__ __forceinline__ void p0_expert_run(Frame& F, int base, int start, int stride, int end, LAS unsigned* scr) {
    int it = start;
    if (it >= end) return;
    ExpItem cur = exp_item(F, base + it), nxt = cur;
    f4nt A[16], B[16];
    exp_issue(cur, 0, A);
    for (;;) {
        const int itn = it + stride; const bool has = itn < end;
        if (has) nxt = exp_item(F, base + itn);
        exp_issue(cur, 1, B); exp_consume(A, 0, scr, F.lane);
        exp_issue(cur, 2, A); exp_consume(B, 1, scr, F.lane);
        exp_issue(cur, 3, B); exp_consume(A, 2, scr, F.lane);
        if (has) exp_issue(nxt, 0, A);
        exp_consume(B, 3, scr, F.lane);
        exp_flush(cur, scr, F.lane);
        if (!has) break;
        cur = nxt; it = itn;
    }
}
__device__ __forceinline__ void p1_deferred_items(Frame& F) {
    if (F.G != 256 || F.bx < P1_IDLE0) { if (F.G != 256) { LAS unsigned* scr = (LAS unsigned*)(F.lds + F.wave * 16896); p0_expert_run(F, P0_IEXP - P0_DEFER, F.vcu * NWAVES + F.wave, F.G * NWAVES, P0_DEFER, scr); } return; }
    LAS unsigned* scr = (LAS unsigned*)(F.lds + F.wave * 16896);
    p0_expert_run(F, P0_IEXP - P0_DEFER, (F.bx - P1_IDLE0) * NWAVES + F.wave, (256 - P1_IDLE0) * NWAVES, P0_DEFER, scr);
}
__device__ __forceinline__ void p0_prologue(Frame& F) {
    LAS unsigned* scr = (LAS unsigned*)(F.lds + F.wave * 16896);
    const int gw = F.vcu * NWAVES + F.wave, NGW = F.G * NWAVES;
    const float* w_in = F.in[3]; const float* w_kv = F.in[14]; const float* w_out = F.in[15];
    f16* WinT = (f16*)(F.ws + WS_WINT); f16* WoutT = (f16*)(F.ws + WS_WOUTT); f16* WkvT = (f16*)(F.ws + WS_WKVT);
    constexpr int I_IN = 8 * (DIN / 64), I_OUT = 8 * (D / 64), I_KV = 8 * (2 * DX / 64);
    constexpr int NITEMS = I_IN + I_OUT + I_KV + (P0_IEXP - P0_DEFER);
    p0_expert_run(F, 0, gw, NGW, P0_IEXP - P0_DEFER, scr);
    for (int it = (P0_IEXP - P0_DEFER) / NGW * NGW + gw; it < NITEMS; it += NGW) {
        int r = it;
        if (r < P0_IEXP - P0_DEFER) continue;
        r -= (P0_IEXP - P0_DEFER);
        if (r < I_IN) { const int nb = r >> 3, kb = r & 7; p0_transpose_item(w_in, DIN, kb * 128, nb * 64, WinT, nb * 64, scr, F.lane); continue; } r -= I_IN;
        if (r < I_OUT) { const int nb = r >> 3, kb = r & 7; p0_transpose_item(w_out, D, kb * 128, nb * 64, WoutT, nb * 64, scr, F.lane); continue; } r -= I_OUT;
        { const int nb = r >> 3, kb = r & 7; p0_transpose_item(w_kv, 2 * DX, kb * 128, nb * 64, WkvT, nb * 64, scr, F.lane); }
    }
    f16* H0 = (f16*)(F.ws + WS_H0); f16* MEMN = (f16*)(F.ws + WS_MEMN);
    for (int m = gw; m < T + BATCH * NMEM; m += NGW) {
        if (m < T) rms_row_f16(F.in[0] + (size_t)m * D, F.in[2], H0 + (size_t)m * D, F.lane);
        else rms_row_f16(F.in[1] + (size_t)(m - T) * D, F.in[13], MEMN + (size_t)(m - T) * D, F.lane);
    }
    { unsigned long long* agz = (unsigned long long*)(F.ws + WS_AGG) + (size_t)F.bx * DRNN; if (F.bx < T / 64) agz[F.tid] = 0ull; if (F.bx < 16) agz[(size_t)256 * DRNN + F.tid] = 0ull; }
    if (gw == 0) { u32x4* z = (u32x4*)(F.ws + WS_X1N + (size_t)T * D); z[F.lane] = (u32x4){0u, 0u, 0u, 0u}; if (F.lane == 0) ((float*)(F.ws + WS_TOPG))[TK] = 0.f; }
}

struct SchedP1 {
    static constexpr bool GATHER = false, PREFETCH = false, HALVES = false;
    const char* H0; const char* WinT; const char* MEMN; const char* WkvT; int G, c;
    __device__ __forceinline__ bool next(int i, pg::Unit& u) const {
        constexpr int NP = 64 * 6;
        int L;
        if (G == 256) {
            if (c < P1_NGEMM) { L = i * P1_NGEMM + c; if (L >= NP) return false; }
            else { if (i > 0 || c >= P1_NGEMM + 4) return false; L = NP + (c - P1_NGEMM); }
        } else { L = i * G + c; if (L >= NP + 4) return false; }
        if (L < NP) {
            int wgid = L; { const int q = NP / 8, xcd = wgid % 8, off = wgid / 8; wgid = xcd * q + off; }
            const int nig = 8 * 6, gid = wgid / nig, fm = gid * 8;
            u.pm = fm + ((wgid % nig) % 8); u.pn = (wgid % nig) / 8; u.kind = 0;
            u.A = H0 + (size_t)u.pm * 256 * pg::ROWB; u.B = WinT + (size_t)u.pn * 256 * pg::ROWB;
                    u.e = 0; u.hrow = u.pm * 256; u.p0 = u.pn * 256; u.cnt = DIN;
        } else {
            const int q = L - NP, b = q >> 1, v = q & 1; u.pm = b; u.pn = v; u.kind = 1; u.e = 1 + q; u.hrow = 0; u.p0 = 0; u.cnt = DX;
            const char* mb = MEMN + (size_t)b * 256 * pg::ROWB; const char* wv = WkvT + (size_t)v * 256 * pg::ROWB;
            u.A = v ? wv : mb; u.B = v ? mb : wv; }
        return true;
    }
    __device__ __forceinline__ void rows(const pg::Unit&, int R0, unsigned colb, unsigned (&ar)[4]) const { pg::dense_rows(R0, colb, ar); }
};
struct EpiP1 {
    static constexpr bool PERM = true, FP8 = false;
    f16* proj; f16* Kh; f16* VT;
    __device__ __forceinline__ void init(f32x4 (&acc)[2][2][4][2], const pg::Unit&, int, int, int, int) const { pg::zero_acc(acc); }
    __device__ __forceinline__ void prefetch(const pg::Unit&, int, int, unsigned) const {}
    __device__ __forceinline__ void operator()(const f32x4 (&acc)[2][2][4][2], const pg::Unit& u, int wr, int wc, int fr, int fq, const LAS unsigned char*) const {
        f16* base = proj;
        if (u.e != 0) { const int q = u.e - 1; base = ((q & 1) ? VT : Kh) + (size_t)(q >> 1) * NMEM * DX; }
        const int ld = u.cnt;
        const int row0 = u.hrow + wr * 64 + fr, col0 = u.p0 + wc * 32 + 8 * fq;
#pragma unroll
        for (int ai = 0; ai < 2; ++ai)
#pragma unroll
            for (int m = 0; m < 4; ++m) { f16* rowp = base + (size_t)(row0 + ai * 128 + m * 16) * ld + col0;
#pragma unroll
                for (int bj = 0; bj < 2; ++bj) { const f32x4 v0 = acc[ai][bj][m][0], v1 = acc[ai][bj][m][1];
                    u32x4 w; w.x = pk_f16(v0[0], v0[1]); w.y = pk_f16(v0[2], v0[3]); w.z = pk_f16(v1[0], v1[1]); w.w = pk_f16(v1[2], v1[3]);
                    *(u32x4*)(rowp + bj * 128) = w; } }
    }
};

struct SchedP3 {
    static constexpr bool GATHER = false, PREFETCH = false, HALVES = false;
    const char* MIX; const char* WoutT; int L;
    __device__ __forceinline__ bool next(int i, pg::Unit& u) const {
        constexpr int NP = 64 * 4;
        if (i > 0 || L >= NP) return false;
        int wgid = L; { const int q = NP / 8, xcd = wgid % 8, off = wgid / 8; wgid = xcd * q + off; }
        const int nig = 8 * 4, gid = wgid / nig, fm = gid * 8;
        u.pm = fm + ((wgid % nig) % 8); u.pn = (wgid % nig) / 8; u.kind = 0;
        u.A = MIX + (size_t)u.pm * 256 * pg::ROWB; u.B = WoutT + (size_t)u.pn * 256 * pg::ROWB;
        u.e = 0; u.p0 = 0; u.cnt = 0; u.hrow = 0;
        return true;
    }
    __device__ __forceinline__ void rows(const pg::Unit&, int R0, unsigned colb, unsigned (&ar)[4]) const { pg::dense_rows(R0, colb, ar); }
};
struct EpiP3 {
    static constexpr bool PERM = true, FP8 = false;
    const float* x; f16* x1; unsigned char* x1g8; const float* gffn; const f16* WrH; float* PARTL; float* SSQP; LAS unsigned char* lds;
    __device__ __forceinline__ void init(f32x4 (&acc)[2][2][4][2], const pg::Unit& u, int wr, int wc, int fr, int fq) const {
        const float* xp = x + (size_t)(u.pm * 256 + wr * 64 + fr) * D + u.pn * 256 + wc * 32 + 8 * fq;
#pragma unroll
        for (int ai = 0; ai < 2; ++ai)
#pragma unroll
            for (int m = 0; m < 4; ++m)
#pragma unroll
                for (int bj = 0; bj < 2; ++bj)
#pragma unroll
                    for (int n = 0; n < 2; ++n) acc[ai][bj][m][n] = __builtin_nontemporal_load((const f32x4*)(xp + (size_t)(ai * 128 + m * 16) * D + bj * 128 + 4 * n));
    }
    __device__ __forceinline__ void prefetch(const pg::Unit&, int, int, unsigned) const {}
    __device__ __forceinline__ void operator()(const f32x4 (&acc)[2][2][4][2], const pg::Unit& u, int wr, int wc, int fr, int fq, const LAS unsigned char*) const {
        const int wave = wr * 4 + wc;
        const int row0 = u.pm * 256 + wr * 64 + fr, col0 = u.pn * 256 + wc * 32 + 8 * fq;
        f16x8 wrh[2][2], wrl[2][2];
        f32x4 gg[2][2];
#pragma unroll
        for (int bj = 0; bj < 2; ++bj) {
#pragma unroll
            for (int eh = 0; eh < 2; ++eh) { const size_t o = (size_t)(16 * eh + fr) * D + col0 + 128 * bj; wrh[bj][eh] = *(const f16x8*)(WrH + o); wrl[bj][eh] = *(const f16x8*)(WrH + (size_t)NE * D + o); }
            gg[bj][0] = *(const f32x4*)(gffn + col0 + 128 * bj) * SC_X; gg[bj][1] = *(const f32x4*)(gffn + col0 + 128 * bj + 4) * SC_X;
        }
        asm volatile("s_waitcnt vmcnt(0)" ::: "memory");
        __builtin_amdgcn_s_barrier();
        LAS float* PL = (LAS float*)lds + wave * (128 * 32);
        LAS float* SS = (LAS float*)(lds + LDS_EPI_OFF) + wave * 128;
#pragma unroll
        for (int ai = 0; ai < 2; ++ai)
#pragma unroll
            for (int p = 0; p < 2; ++p) {
                u32x2 wv[2][2];
#pragma unroll
                for (int mm = 0; mm < 2; ++mm) {
                    const int m = 2 * p + mm;
                    const size_t off = (size_t)(row0 + ai * 128 + m * 16) * D + col0;
                    f32x4 L0 = {0.f, 0.f, 0.f, 0.f}, L1 = {0.f, 0.f, 0.f, 0.f}; float ss = 0.f;
#pragma unroll
                    for (int bj = 0; bj < 2; ++bj) {
                        const f32x4 v0 = acc[ai][bj][m][0], v1 = acc[ai][bj][m][1];
                        u32x4 w; w.x = pk_f16(v0[0], v0[1]); w.y = pk_f16(v0[2], v0[3]); w.z = pk_f16(v1[0], v1[1]); w.w = pk_f16(v1[2], v1[3]);
                        *(u32x4*)(x1 + off + bj * 128) = w;
                        const f16x8 hv = __builtin_bit_cast(f16x8, w);
                        const f32x4 h0 = {(float)hv[0], (float)hv[1], (float)hv[2], (float)hv[3]}, h1 = {(float)hv[4], (float)hv[5], (float)hv[6], (float)hv[7]};
                        ss += ((h0[0] * h0[0] + h0[1] * h0[1]) + (h0[2] * h0[2] + h0[3] * h0[3])) + ((h1[0] * h1[0] + h1[1] * h1[1]) + (h1[2] * h1[2] + h1[3] * h1[3]));
                        const f32x4 q0 = h0 * gg[bj][0], q1 = h1 * gg[bj][1];
                        wv[mm][bj].x = pk4_fp8(q0[0], q0[1], q0[2], q0[3]); wv[mm][bj].y = pk4_fp8(q1[0], q1[1], q1[2], q1[3]);
                        L0 = __builtin_amdgcn_mfma_f32_16x16x32_f16(wrh[bj][0], hv, L0, 0, 0, 0); L1 = __builtin_amdgcn_mfma_f32_16x16x32_f16(wrh[bj][1], hv, L1, 0, 0, 0);
                        L0 = __builtin_amdgcn_mfma_f32_16x16x32_f16(wrl[bj][0], hv, L0, 0, 0, 0); L1 = __builtin_amdgcn_mfma_f32_16x16x32_f16(wrl[bj][1], hv, L1, 0, 0, 0);
                    }
                    const int rl = (ai * 4 + m) * 16 + fr;
                    *(LAS f32x4*)(PL + rl * 32 + 4 * fq) = L0; *(LAS f32x4*)(PL + rl * 32 + 16 + 4 * fq) = L1;
                    ss += __shfl_xor(ss, 16); ss += __shfl_xor(ss, 32);
                    if (fq == 0) SS[rl] = ss;
                }
#pragma unroll
                for (int bj = 0; bj < 2; ++bj) {
                    const auto rx = __builtin_amdgcn_permlane16_swap(wv[0][bj].x, wv[1][bj].x, false, false);
                    const auto ry = __builtin_amdgcn_permlane16_swap(wv[0][bj].y, wv[1][bj].y, false, false);
                    const int r = row0 + ai * 128 + (2 * p + (fq & 1)) * 16;
                    u32x4 w16; w16.x = rx[0]; w16.y = ry[0]; w16.z = rx[1]; w16.w = ry[1];
                    *(u32x4*)(x1g8 + (size_t)r * D + u.pn * 256 + wc * 32 + 16 * (fq >> 1) + bj * 128) = w16;
                }
            }
        asm volatile("s_waitcnt lgkmcnt(0)" ::: "memory");
        __builtin_amdgcn_s_barrier();
        {
            const int t = (int)threadIdx.x, r256 = t >> 1, eh = t & 1;
            const int ai_ = r256 >> 7, wr_ = (r256 >> 6) & 1, rl = (ai_ * 4 + ((r256 >> 4) & 3)) * 16 + (r256 & 15);
            const LAS float* pl = (const LAS float*)lds + (wr_ * 4) * (128 * 32) + rl * 32 + 16 * eh;
            const size_t grow = (size_t)u.pn * T + (size_t)u.pm * 256 + r256;
#pragma unroll
            for (int q = 0; q < 4; ++q) {
                f32x4 sum = *(const LAS f32x4*)(pl + 4 * q);
#pragma unroll
                for (int c = 1; c < 4; ++c) sum += *(const LAS f32x4*)(pl + c * (128 * 32) + 4 * q);
                *(f32x4*)(PARTL + grow * 32 + 16 * eh + 4 * q) = sum;
            }
            if (eh == 0) { const LAS float* sp = (const LAS float*)(lds + LDS_EPI_OFF) + (wr_ * 4) * 128 + rl; SSQP[grow] = ((sp[0] + sp[128]) + sp[256]) + sp[384]; }
        }
    }
};

template <int NCT, bool GATHER_> struct SchedMoe {
    static constexpr bool GATHER = GATHER_, PREFETCH = true, HALVES = true;
    const char* Abase; const char* Wbase; size_t wstride_e; const int* list; const LAS int* tab; int G, c;
    __device__ __forceinline__ bool next(int i, pg::Unit& u) const {
        const int ntiles = __builtin_amdgcn_readfirstlane(tab[NE]);
        const int per = G >> 3;
        const int U = ntiles * NCT, Uc = (U + 7) / 8, x = c & 7, j = c >> 3;
        int Ux = U - x * Uc; Ux = Ux < 0 ? 0 : (Ux > Uc ? Uc : Ux);
        const int nfull = Ux / per, rem = Ux - nfull * per;
        int Lx, half = 0;
        if (i < nfull) Lx = j + per * i;
        else if (i == nfull && rem > 0) {
            if (2 * rem <= per) { if (j >= 2 * rem) return false; Lx = nfull * per + (j >> 1); half = 1 + (j & 1); }
            else { if (j >= rem) return false; Lx = nfull * per + j; }
        } else return false;
        const int L = x * Uc + Lx;
        const int RT = L / NCT, ct = L % NCT;
        const int ln = (int)(threadIdx.x & 63u);
        const unsigned long long mm = __ballot((ln < NE) && (tab[ln & 31] <= RT));
        const int e = 63 - __builtin_clzll(mm);
        const int t0 = __builtin_amdgcn_readfirstlane(tab[e]);
        u.e = e; u.p0 = (RT - t0) * 256; u.cnt = __builtin_amdgcn_readfirstlane(tab[40 + e]); u.hrow = RT * 256; u.pn = ct; u.pm = RT;
        if (half == 0 && u.cnt - u.p0 <= 128) half = 1;
        u.kind = half;
        u.B = Wbase + (size_t)e * wstride_e + (size_t)ct * 256 * pg::ROWB8;
        u.A = GATHER_ ? Abase : Abase + (size_t)u.hrow * pg::ROWB8;
        return true;
    }
    __device__ __forceinline__ void rows_issue(const pg::Unit& u, int R0, unsigned (&raw)[4]) const {
        const int idx = __builtin_amdgcn_readfirstlane(u.e * T + u.p0);
        const char* lb = (const char*)(list + idx);
        const unsigned off = (unsigned)R0 * 4u;
        asm volatile("global_load_dword %0, %4, %5\n\tglobal_load_dword %1, %4, %5 offset:256\n\tglobal_load_dword %2, %4, %5 offset:512\n\tglobal_load_dword %3, %4, %5 offset:768"
                     : "=&v"(raw[0]), "=&v"(raw[1]), "=&v"(raw[2]), "=&v"(raw[3]) : "v"(off), "s"(lb) : "memory");
    }
    __device__ __forceinline__ void rows_finish(const pg::Unit& u, int R0, unsigned colb, const unsigned (&raw)[4], unsigned (&ar)[4]) const {
#pragma unroll
        for (int q = 0; q < 4; ++q) { const int pos = u.p0 + R0 + 64 * q; const unsigned tok = (pos < u.cnt) ? (raw[q] >> 2) : (unsigned)T; ar[q] = tok * pg::ROWB8 + colb; }
    }
    __device__ __forceinline__ void rows(const pg::Unit& u, int R0, unsigned colb, unsigned (&ar)[4]) const {
        if (GATHER_) {
#pragma unroll
            for (int q = 0; q < 4; ++q) { const int pos = u.p0 + R0 + 64 * q; const int posc = pos < u.cnt ? pos : u.cnt - 1; const int le = list[u.e * T + posc]; const int tok = pos < u.cnt ? (le >> 2) : T; ar[q] = (unsigned)tok * pg::ROWB8 + colb; }
        } else pg::dense_rows<pg::ROWB8>(R0, colb, ar);
    }
};
struct EpiGU {
    static constexpr bool PERM = true, FP8 = true;
    const float* b_gu; const float* rlist; unsigned char* Hbuf; int skip;
    __device__ __forceinline__ void init(f32x4 (&acc)[2][2][4][2], const pg::Unit&, int, int, int, int) const { pg::zero_acc(acc); }
    __device__ __forceinline__ void prefetch(const pg::Unit& u, int wid, int lane, unsigned slot) const {
        if (wid == 0) { const unsigned voff = (unsigned)((lane < 32 ? (u.pn * 128 + 4 * lane) : (DFF + u.pn * 128 + 4 * (lane - 32))) * 4); pg::glds16n(pg::uptr((const char*)(b_gu + (size_t)u.e * 2 * DFF)), voff, slot);
            pg::glds16n(pg::uptr((const char*)(rlist + (size_t)u.e * T + u.p0)), (unsigned)lane * 16u, slot + 1024u); }
    }
    __device__ __forceinline__ void operator()(const f32x4 (&acc)[2][2][4][2], const pg::Unit& u, int wr, int wc, int fr, int fq, const LAS unsigned char* slot) const {
        if (skip) return;
        const int cj = u.pn * 128 + wc * 32 + 8 * fq;
        f32x4 bgv[2], buv[2];
#pragma unroll
        for (int n = 0; n < 2; ++n) { bgv[n] = *(const LAS f32x4*)(slot + (wc * 32 + 8 * fq + 4 * n) * 4); buv[n] = *(const LAS f32x4*)(slot + 512 + (wc * 32 + 8 * fq + 4 * n) * 4); }
        const int cj16 = u.pn * 128 + wc * 32 + 16 * (fq >> 1);
#pragma unroll
        for (int ai = 0; ai < 2; ++ai) {
            if (u.kind == 2 - ai) continue;
            u32x2 wv[4];
#pragma unroll
            for (int m = 0; m < 4; ++m) {
                float o[8];
                const int rl = ai * 128 + wr * 64 + m * 16 + fr;
                const float rsc = ((u.p0 + rl) < u.cnt ? ((const LAS float*)(slot + 1024))[rl] : 0.f) * (1.f / (SC_W * SC_X));
#pragma unroll
                for (int n = 0; n < 2; ++n)
#pragma unroll
                    for (int j = 0; j < 4; j += 2) {
                        constexpr float c1 = -1.702f * 1.4426950408889634f, kk = SC_H / c1;
                        const f32x2 ag = {acc[ai][0][m][n][j], acc[ai][0][m][n][j + 1]}, au_ = {acc[ai][1][m][n][j], acc[ai][1][m][n][j + 1]};
                        const f32x2 bg2 = {bgv[n][j], bgv[n][j + 1]}, bu2 = {buv[n][j], buv[n][j + 1]};
                        f32x2 t = ag * (rsc * c1) + bg2 * c1, uv = au_ * rsc + bu2;
                        t[0] = fmaxf(t[0], 7.f * c1); t[1] = fmaxf(t[1], 7.f * c1);
                        uv[0] = __builtin_amdgcn_fmed3f(uv[0], -7.f, 7.f); uv[1] = __builtin_amdgcn_fmed3f(uv[1], -7.f, 7.f);
                        f32x2 e2 = {__builtin_amdgcn_exp2f(t[0]), __builtin_amdgcn_exp2f(t[1])};
                        e2 = e2 + 1.f;
                        const f32x2 sg = {__builtin_amdgcn_rcpf(e2[0]), __builtin_amdgcn_rcpf(e2[1])};
                        const f32x2 ov = (uv * kk + kk) * (t * sg);
                        o[4 * n + j] = ov[0]; o[4 * n + j + 1] = ov[1];
                    }
                wv[m].x = pk4_fp8(o[0], o[1], o[2], o[3]); wv[m].y = pk4_fp8(o[4], o[5], o[6], o[7]);
            }
#pragma unroll
            for (int p = 0; p < 2; ++p) {
                const auto rx = __builtin_amdgcn_permlane16_swap(wv[2 * p].x, wv[2 * p + 1].x, false, false);
                const auto ry = __builtin_amdgcn_permlane16_swap(wv[2 * p].y, wv[2 * p + 1].y, false, false);
                const int r = ai * 128 + wr * 64 + (2 * p + (fq & 1)) * 16 + fr;
                u32x4 w16; w16.x = rx[0]; w16.y = ry[0]; w16.z = rx[1]; w16.w = ry[1];
                *(u32x4*)(Hbuf + (size_t)(u.hrow + r) * DFF + cj16) = w16;
            }
        }
    }
};
struct EpiDown {
    static constexpr bool PERM = true, FP8 = true;
    const float* b_down; const int* list; const float* glist; unsigned char* Y; int skip;
    __device__ __forceinline__ void init(f32x4 (&acc)[2][2][4][2], const pg::Unit&, int, int, int, int) const { pg::zero_acc(acc); }
    __device__ __forceinline__ void prefetch(const pg::Unit& u, int wid, int lane, unsigned slot) const {
        if (wid == 0) { const unsigned voff = (unsigned)lane * 16u;
            pg::glds16n(pg::uptr((const char*)(b_down + (size_t)u.e * D + u.pn * 256)), voff, slot);
            pg::glds16n(pg::uptr((const char*)(list + (size_t)u.e * T + u.p0)), voff, slot + 1024u);
            pg::glds16n(pg::uptr((const char*)(glist + (size_t)u.e * T + u.p0)), voff, slot + 2048u); }
    }
    __device__ __forceinline__ void operator()(const f32x4 (&acc)[2][2][4][2], const pg::Unit& u, int wr, int wc, int fr, int fq, const LAS unsigned char* slotp) const {
        if (skip) return;
        const int c0 = u.pn * 256 + wc * 32 + 8 * fq;
        f32x4 bv[2][2];
#pragma unroll
        for (int bj = 0; bj < 2; ++bj)
#pragma unroll
            for (int n = 0; n < 2; ++n) bv[bj][n] = *(const LAS f32x4*)(slotp + (bj * 128 + wc * 32 + 8 * fq + 4 * n) * 4);
        const int c16 = u.pn * 256 + wc * 32 + 16 * (fq >> 1);
#pragma unroll
        for (int ai = 0; ai < 2; ++ai) {
            if (u.kind == 2 - ai) continue;
#pragma unroll
            for (int p = 0; p < 2; ++p) {
                const int rA = ai * 128 + wr * 64 + (2 * p) * 16 + fr, rB = rA + 16;
                const int slA = ((const LAS int*)(slotp + 1024))[rA], slB = ((const LAS int*)(slotp + 1024))[rB];
                const float glA = ((const LAS float*)(slotp + 2048))[rA], glB = ((const LAS float*)(slotp + 2048))[rB];
                const bool okA = (u.p0 + rA) < u.cnt, okB = (u.p0 + rB) < u.cnt;
                const int slotA = okA ? slA : TK, slotB = okB ? slB : TK;
                const float gtA = (okA ? glA : 0.f) * SC_Y, gtB = (okB ? glB : 0.f) * SC_Y;
                const int slot = (fq & 1) ? slotB : slotA;
                unsigned char* rowp = Y + (size_t)slot * D + c16;
#pragma unroll
                for (int bj = 0; bj < 2; ++bj) {
                    const f32x4 a0 = (acc[ai][bj][2 * p][0] * (1.f / (SC_W * SC_H)) + bv[bj][0]) * gtA, a1 = (acc[ai][bj][2 * p][1] * (1.f / (SC_W * SC_H)) + bv[bj][1]) * gtA;
                    const f32x4 b0 = (acc[ai][bj][2 * p + 1][0] * (1.f / (SC_W * SC_H)) + bv[bj][0]) * gtB, b1 = (acc[ai][bj][2 * p + 1][1] * (1.f / (SC_W * SC_H)) + bv[bj][1]) * gtB;
                    const unsigned ax = pk4_fp8(a0[0], a0[1], a0[2], a0[3]), ay = pk4_fp8(a1[0], a1[1], a1[2], a1[3]);
                    const unsigned bx = pk4_fp8(b0[0], b0[1], b0[2], b0[3]), by = pk4_fp8(b1[0], b1[1], b1[2], b1[3]);
                    const auto rx = __builtin_amdgcn_permlane16_swap(ax, bx, false, false);
                    const auto ry = __builtin_amdgcn_permlane16_swap(ay, by, false, false);
                    u32x4 w16; w16.x = rx[0]; w16.y = ry[0]; w16.z = rx[1]; w16.w = ry[1];
                    *(u32x4*)(rowp + bj * 128) = w16;
                }
            }
        }
    }
};
__device__ __forceinline__ void moe_table(Frame& F) {
    LAS int* tab = (LAS int*)(F.lds + LDS_CTL_OFF + 256);
    if (F.tid == 0) { int tt = 0; for (int e = 0; e < NE; ++e) { const int c = (int)F.ctl[CW_COUNTS + 64 * e]; tab[e] = tt; tab[40 + e] = c; tt += (c + 255) >> 8; } tab[NE] = tt; }
    __syncthreads();
}

constexpr size_t SW_WAT = 0, SW_WIT = 64 * 1024, SW_WPT = 128 * 1024, SW_WRP = 256 * 1024;
__device__ __forceinline__ void p0_small(Frame& F) {
    const int gt = F.vcu * (NWAVES * 64) + F.tid, NTH = F.G * NWAVES * 64;
    f16* WaT = (f16*)(F.ws + WS_SMALLW + SW_WAT); f16* WiT = (f16*)(F.ws + WS_SMALLW + SW_WIT); f16* WpT = (f16*)(F.ws + WS_SMALLW + SW_WPT); f16* WrH = (f16*)(F.ws + WS_SMALLW + SW_WRP); f16* WrL = WrH + NE * D;
    const float* w_a = F.in[6]; const float* w_i = F.in[8]; const float* w_p = F.in[11]; const float* gffn = F.in[16]; const float* w_r = F.in[17];
    for (int idx = gt; idx < NH * 64 * 64; idx += NTH) { const int h = idx >> 12, j = (idx >> 6) & 63, i = idx & 63; WaT[idx] = (f16)w_a[(h * 64 + i) * 64 + j]; WiT[idx] = (f16)w_i[(h * 64 + i) * 64 + j]; }
    for (int idx = gt; idx < 4 * 64 * 64; idx += NTH) { const int g = idx >> 12, j = (idx >> 6) & 63, i = idx & 63; WpT[idx] = (f16)w_p[(g * 64 + i) * 64 + j]; }
    for (int idx = gt; idx < D * NE; idx += NTH) { const int k = idx >> 5, e = idx & 31; const float wv = 1024.f * (gffn[k] * w_r[idx]); const f16 hh = (f16)wv; WrH[e * D + k] = hh; WrL[e * D + k] = (f16)(wv - (float)hh); }
}

typedef float f32x16 __attribute__((ext_vector_type(16)));
constexpr int UCS_PITCH = 520;
constexpr int DT_PITCH = 264;
constexpr int P2_DT_OFF = 64 * UCS_PITCH * 2;
constexpr int P2_STG_OFF = P2_DT_OFF + 64 * DT_PITCH * 2;
constexpr float LOG2E = 1.4426950408889634f;
__device__ __forceinline__ float sigmoid_fast(float x) { return __builtin_amdgcn_rcpf(1.f + __builtin_amdgcn_exp2f(-x * LOG2E)); }
__device__ __forceinline__ float gelu_tanh_fast(float x) {
    const float u2 = 1.5957691216057308f * (x + 0.044715f * x * x * x);
    return x * sigmoid_fast(u2);
}
template <int W> __device__ __forceinline__ void pool_d2(const unsigned* up2, int tpos0, LAS unsigned* dst) {
    f32x2 u[16 + W - 1];
#pragma unroll
    for (int i = 0; i < 16 + W - 1; ++i) {
        const int rel = i - (W - 1), lim = -tpos0, rc = rel < lim ? lim : rel;
        const unsigned ld = up2[(ptrdiff_t)rc * (DIN / 2)];
        const unsigned raw = (rel >= lim) ? ld : 0u;
        const f16x2 h = __builtin_bit_cast(f16x2, raw);
        u[i] = (f32x2){(float)h[0], (float)h[1]};
    }
#pragma unroll
    for (int t = 0; t < 16; ++t) {
        f32x2 sacc = {0.f, 0.f};
#pragma unroll
        for (int q = 0; q < W; ++q) sacc += u[t + (W - 1) - q];
        const int n = (tpos0 + t + 1 < W) ? (tpos0 + t + 1) : W;
        const float rn = 1.f / (float)n;
        const f32x2 d = sacc * rn - u[t + W - 1];
        dst[t * (DT_PITCH / 2)] = pk_f16(d[0], d[1]);
    }
}
__device__ __forceinline__ void lookback16(const unsigned long long* base, int n, float& la, float& lh) {
    unsigned long long g[16];
    for (unsigned spin = 0;; ++spin) {
        bool ok = true;
#pragma unroll
        for (int i = 0; i < 16; ++i) { const int k = i < n ? i : (n > 0 ? n - 1 : 0);
            g[i] = __hip_atomic_load((unsigned long long*)base + (size_t)k * DRNN, __ATOMIC_RELAXED, __HIP_MEMORY_SCOPE_AGENT);
            if (i < n) ok = ok && ((unsigned)g[i] != 0u); }
        if (ok || spin > (1u << 18)) break;
        __builtin_amdgcn_s_sleep(2);
    }
    la = 1.f; lh = 0.f;
#pragma unroll
    for (int i = 0; i < 16; ++i) if (i < n) { const float a = __uint_as_float((unsigned)g[i]), hh = __uint_as_float((unsigned)(g[i] >> 32)); lh = a * lh + hh; la = a * la; }
}
__device__ __forceinline__ void p2_mixer(Frame& F) {
    const f16* proj = (const f16*)(F.ws + WS_PROJ);
    f16* mixed = (f16*)(F.ws + WS_MIXED);
    unsigned long long* AGG = (unsigned long long*)(F.ws + WS_AGG);
    const f16* WaT = (const f16*)(F.ws + WS_SMALLW + SW_WAT); const f16* WiT = (const f16*)(F.ws + WS_SMALLW + SW_WIT); const f16* WpT = (const f16*)(F.ws + WS_SMALLW + SW_WPT);
    const f16* Kh = (const f16*)(F.ws + WS_KH); const f16* VT = (const f16*)(F.ws + WS_VT);
    const float* conv_w = F.in[4]; const float* conv_b = F.in[5]; const float* b_a = F.in[7]; const float* b_i = F.in[9]; const float* lam = F.in[10]; const float* pool_scale = F.in[12];
    LAS f16* ucs = (LAS f16*)(F.lds); LAS f16* dts = (LAS f16*)(F.lds + P2_DT_OFF);
    const int w = F.wave;
    const int sub = F.flags ? F.flags : 31;
    for (int ch = F.bx; ch < T / 64; ch += F.G) {
        int tid = F.tid; asm volatile("" : "+v"(tid));
        const int lane = tid & 63, hi = lane >> 5, l31 = lane & 31;
        const int tok0 = ch * 64, t0 = tok0 % SEQ, b = tok0 / SEQ;
        if (sub & 1) {
            const int cp = tid & 255, th = tid >> 8, c0 = 2 * cp;
            const f32x2 cw0 = *(const f32x2*)(conv_w + c0), cw1 = *(const f32x2*)(conv_w + DRNN + c0), cw2 = *(const f32x2*)(conv_w + 2 * DRNN + c0), cw3 = *(const f32x2*)(conv_w + 3 * DRNN + c0), cbv = *(const f32x2*)(conv_b + c0);
            const unsigned* up2 = (const unsigned*)(proj + (size_t)(tok0 + 32 * th) * DIN + c0);
            unsigned raw[35];
#pragma unroll
            for (int i = 0; i < 35; ++i) {
                const int rel = i - 3, lim = -(t0 + 32 * th), rc = rel < lim ? lim : rel;
                const unsigned v = up2[(ptrdiff_t)rc * (DIN / 2)];
                raw[i] = (rel >= lim) ? v : 0u;
            }
            LAS unsigned* dstc = (LAS unsigned*)(ucs + (32 * th) * UCS_PITCH + c0);
            f32x2 u0, u1, u2;
            { const f16x2 h0 = __builtin_bit_cast(f16x2, raw[0]), h1 = __builtin_bit_cast(f16x2, raw[1]), h2 = __builtin_bit_cast(f16x2, raw[2]);
              u0 = (f32x2){(float)h0[0], (float)h0[1]}; u1 = (f32x2){(float)h1[0], (float)h1[1]}; u2 = (f32x2){(float)h2[0], (float)h2[1]}; }
#pragma unroll
            for (int t = 0; t < 32; ++t) {
                const f16x2 h3 = __builtin_bit_cast(f16x2, raw[t + 3]);
                const f32x2 u3 = (f32x2){(float)h3[0], (float)h3[1]};
                const f32x2 v = cbv + cw0 * u0 + cw1 * u1 + cw2 * u2 + cw3 * u3;
                dstc[t * (UCS_PITCH / 2)] = pk_f16(v[0], v[1]);
                u0 = u1; u1 = u2; u2 = u3;
            }
        }
        if (sub & 2) {
            const int g = w & 3, half = w >> 2, cpl = lane & 31, q2 = lane >> 5, ts = 32 * half + 16 * q2, c0 = 64 * g + 2 * cpl;
            const unsigned* pp2 = (const unsigned*)(proj + (size_t)(tok0 + ts) * DIN + 2 * DRNN + c0);
            LAS unsigned* dst = (LAS unsigned*)(dts + ts * DT_PITCH + c0);
            if (g == 0) pool_d2<2>(pp2, t0 + ts, dst); else if (g == 1) pool_d2<4>(pp2, t0 + ts, dst); else if (g == 2) pool_d2<8>(pp2, t0 + ts, dst); else pool_d2<16>(pp2, t0 + ts, dst);
        }
        __syncthreads();
        unsigned sth_[4][8], stp_[4][8];
#pragma unroll
        for (int a = 0; a < 4; ++a)
#pragma unroll
            for (int q = 0; q < 8; ++q) { sth_[a][q] = 0u; stp_[a][q] = 0u; }
        float ownA = 1.f, ownH = 0.f;
        if (sub & 4) {
            const int h = w;
#pragma unroll 1
            for (int cb = 0; cb < 2; ++cb) {
                const int cch = 64 * h + 32 * cb + l31;
                const float ba = b_a[cch], bi = b_i[cch];
                const float sp8 = -8.f * log1pf(expf(-lam[cch]));
                f16x8 wa[4], wi[4], idv[2];
#pragma unroll
                for (int s = 0; s < 4; ++s) {
                    wa[s] = *(const f16x8*)(WaT + ((size_t)(h * 64 + 32 * cb + l31) * 64 + 16 * s + 8 * hi));
                    wi[s] = *(const f16x8*)(WiT + ((size_t)(h * 64 + 32 * cb + l31) * 64 + 16 * s + 8 * hi));
                }
#pragma unroll
                for (int ss = 0; ss < 2; ++ss) {
                    const int jj = l31 - 16 * ss - 8 * hi;
#pragma unroll
                    for (int j = 0; j < 8; ++j) idv[ss][j] = (j == jj) ? (f16)1.f : (f16)0.f;
                }
                float cc = 0.f, Q = 1.f;
#pragma unroll 1
                for (int tb = 0; tb < 2; ++tb) {
                    const LAS f16* arow_ = ucs + (32 * tb + l31) * UCS_PITCH + 64 * h + 8 * hi;
                    f32x16 ar, ai, au;
#pragma unroll
                    for (int r = 0; r < 16; ++r) { ar[r] = 0.f; ai[r] = 0.f; au[r] = 0.f; }
#pragma unroll
                    for (int s = 0; s < 4; ++s) {
                        const f16x8 af = *(const LAS f16x8*)(arow_ + 16 * s);
                        ar = __builtin_amdgcn_mfma_f32_32x32x16_f16(af, wa[s], ar, 0, 0, 0);
                        ai = __builtin_amdgcn_mfma_f32_32x32x16_f16(af, wi[s], ai, 0, 0, 0);
                        if ((s >> 1) == cb) au = __builtin_amdgcn_mfma_f32_32x32x16_f16(af, idv[s & 1], au, 0, 0, 0);
                    }
                    const int tbase = tok0 + 32 * tb + 4 * hi;
                    const f16* gp = proj + (size_t)tbase * DIN + DRNN + cch;
#pragma unroll
                    for (int r = 0; r < 16; ++r) {
                        const int dt = (r & 3) + 8 * (r >> 2);
                        const float rr = sigmoid_fast(ar[r] + ba), ii = sigmoid_fast(ai[r] + bi);
                        const float la = sp8 * rr;
                        const float a = __builtin_amdgcn_exp2f(la * LOG2E);
                        float mult = __builtin_amdgcn_sqrtf(fmaxf(__builtin_fmaf(-a, a, 1.f), 0.f));
                        if (t0 + 32 * tb + 4 * hi + dt == 0) mult = 1.f;
                        ar[r] = a; ai[r] = mult * (ii * au[r]);
                        au[r] = gelu_tanh_fast((float)gp[(size_t)dt * DIN]);
                    }
                    float cin[4], Qin[4];
#pragma unroll
                    for (int rg = 0; rg < 4; ++rg) {
                        float P = ar[4 * rg], hh = ai[4 * rg];
#pragma unroll
                        for (int q = 1; q < 4; ++q) { const float a = ar[4 * rg + q]; hh = a * hh + ai[4 * rg + q]; P = a * P; ar[4 * rg + q] = P; ai[4 * rg + q] = hh; }
                        const float oA = __shfl_xor(P, 32), oH = __shfl_xor(hh, 32);
                        const float A0 = hi ? oA : P, H0 = hi ? oH : hh;
                        const float A1 = hi ? P : oA, H1 = hi ? hh : oH;
                        const float c0 = cc, q0 = Q;
                        cc = A0 * cc + H0; Q = Q * A0;
                        const float c1 = cc, q1 = Q;
                        cc = A1 * cc + H1; Q = Q * A1;
                        cin[rg] = hi ? c1 : c0; Qin[rg] = hi ? q1 : q0;
                    }
#pragma unroll
                    for (int q = 0; q < 8; ++q) { sth_[3][q] = sth_[2][q]; sth_[2][q] = sth_[1][q]; sth_[1][q] = sth_[0][q]; stp_[3][q] = stp_[2][q]; stp_[2][q] = stp_[1][q]; stp_[1][q] = stp_[0][q]; }
#pragma unroll
                    for (int q = 0; q < 8; ++q) {
                        const int r0 = 2 * q, r1 = 2 * q + 1;
                        const float hl0 = ai[r0] + ar[r0] * cin[r0 >> 2], hl1 = ai[r1] + ar[r1] * cin[r1 >> 2];
                        const float pc0 = ar[r0] * Qin[r0 >> 2], pc1 = ar[r1] * Qin[r1 >> 2];
                        sth_[0][q] = pk_f16(hl0 * au[r0], hl1 * au[r1]); stp_[0][q] = pk_f16(pc0 * au[r0], pc1 * au[r1]);
                    }
                }
                if (hi == 0) __hip_atomic_store(AGG + ch * DRNN + cch, ((unsigned long long)__float_as_uint(cc) << 32) | (unsigned long long)__float_as_uint(Q), __ATOMIC_RELAXED, __HIP_MEMORY_SCOPE_AGENT);
                if (cb == hi) { ownA = Q; ownH = cc; }
            }
        }
        const int first = (ch / (SEQ / 64)) * (SEQ / 64), rel = ch - first, grp = rel >> 4, gi = rel & 15, gbase = first + 16 * grp;
        const unsigned long long* agc = AGG + lane + 64 * w;
        unsigned long long* AGG2 = AGG + 256 * DRNN;
        float la = 1.f, lh = 0.f;
        if ((sub & 4) && gi == 15) {
            lookback16(agc + (size_t)gbase * DRNN, 15, la, lh);
            const float ta = ownA * la, thh = ownA * lh + ownH;
            __hip_atomic_store(AGG2 + (size_t)((ch / (SEQ / 64)) * 8 + grp) * DRNN + lane + 64 * w, ((unsigned long long)__float_as_uint(thh) << 32) | __float_as_uint(ta), __ATOMIC_RELAXED, __HIP_MEMORY_SCOPE_AGENT);
        }
        if (sub & 8) {
            const int g = w & 3, th = w >> 2;
            f16x8 Bf[4];
#pragma unroll
            for (int s = 0; s < 4; ++s) Bf[s] = *(const LAS f16x8*)(dts + (32 * th + l31) * DT_PITCH + 64 * g + 16 * s + 8 * hi);
            const size_t tok = (size_t)(tok0 + 32 * th + l31);
#pragma unroll
            for (int cb = 0; cb < 2; ++cb) {
                f32x16 acc;
#pragma unroll
                for (int r = 0; r < 16; ++r) acc[r] = 0.f;
#pragma unroll
                for (int s = 0; s < 4; ++s) { const f16x8 wf = *(const f16x8*)(WpT + ((size_t)(g * 64 + 32 * cb + l31) * 64 + 16 * s + 8 * hi)); acc = __builtin_amdgcn_mfma_f32_32x32x16_f16(wf, Bf[s], acc, 0, 0, 0); }
#pragma unroll
                for (int rg = 0; rg < 4; ++rg) {
                    const int j0 = 32 * cb + 8 * rg + 4 * hi;
                    const f32x4 sc = *(const f32x4*)(pool_scale + 64 * g + j0);
                    u32x2 o; o.x = pk_f16(acc[4 * rg] * sc[0], acc[4 * rg + 1] * sc[1]); o.y = pk_f16(acc[4 * rg + 2] * sc[2], acc[4 * rg + 3] * sc[3]);
                    *(u32x2*)(mixed + tok * D + DRNN + 64 * g + j0) = o;
                }
            }
        }
        if (sub & 4) {
            float ga = 1.f, gh = 0.f;
            if (gi != 15) lookback16(agc + (size_t)gbase * DRNN, gi, la, lh);
            lookback16(AGG2 + (size_t)((ch / (SEQ / 64)) * 8) * DRNN + lane + 64 * w, grp, ga, gh);
            const float carry = la * gh + lh;
            const float carry0 = __shfl(carry, l31), carry1 = __shfl(carry, 32 + l31);
            LAS f16* stg = (LAS f16*)(F.lds + P2_STG_OFF + w * 4096);
#pragma unroll 1
            for (int it = 0; it < 4; ++it) {
                const int cb = it >> 1, tb = it & 1;
                const float cy = cb ? carry1 : carry0;
#pragma unroll
                for (int q = 0; q < 8; ++q) {
                    const f16x2 h2 = __builtin_bit_cast(f16x2, sth_[3][q]), p2 = __builtin_bit_cast(f16x2, stp_[3][q]);
                    const int r0 = 2 * q, r1 = 2 * q + 1;
                    stg[(4 * hi + (r0 & 3) + 8 * (r0 >> 2)) * 32 + l31] = (f16)((float)h2[0] + (float)p2[0] * cy);
                    stg[(4 * hi + (r1 & 3) + 8 * (r1 >> 2)) * 32 + l31] = (f16)((float)h2[1] + (float)p2[1] * cy);
                }
#pragma unroll
                for (int q = 0; q < 8; ++q) { sth_[3][q] = sth_[2][q]; sth_[2][q] = sth_[1][q]; sth_[1][q] = sth_[0][q]; stp_[3][q] = stp_[2][q]; stp_[2][q] = stp_[1][q]; stp_[1][q] = stp_[0][q]; }
                const int tk = lane >> 1, sg2 = lane & 1;
                const u32x4 h0 = *(const LAS u32x4*)(stg + tk * 32 + 8 * sg2), h1 = *(const LAS u32x4*)(stg + tk * 32 + 16 + 8 * sg2);
                const size_t go = (size_t)(tok0 + 32 * tb + tk) * D + 64 * w + 32 * cb + 8 * sg2;
                *(u32x4*)(mixed + go) = h0; *(u32x4*)(mixed + go + 16) = h1;
            }
        }
        if (sub & 16) {
            __syncthreads();
            {
                const char* ksrc = (const char*)(Kh + (size_t)b * NMEM * DX);
#pragma unroll
                for (int j = 0; j < 16; ++j) {
                    const int Pq = tid + 512 * j, key = Pq >> 5, pr = Pq & 31, hd = pr >> 3, chn = pr & 7;
                    const u32x4 v = *(const u32x4*)(ksrc + (size_t)Pq * 16);
                    *(LAS u32x4*)(F.lds + hd * 32768 + key * 128 + ((chn ^ (key & 7)) << 4)) = v;
                }
            }
            const int h = w >> 1, th = w & 1;
            const char* qb = (const char*)(proj + (size_t)(tok0 + 32 * th) * DIN + 2 * DRNN + DPOOL + 64 * h);
            const unsigned qoff = (unsigned)(l31 * DIN + 8 * hi) * 2u;
            f16x8 Qf[4];
#pragma unroll
            for (int s = 0; s < 4; ++s) Qf[s] = *(const f16x8*)(qb + 32 * s + (size_t)qoff);
            const char* vbase = (const char*)(VT + (size_t)b * DX * NMEM + (size_t)(64 * h) * NMEM);
            const unsigned voff = (unsigned)(l31 * NMEM + 8 * hi) * 2u;
            const float scl = 0.125f * LOG2E;
            __syncthreads();
            const LAS unsigned char* kl = F.lds + h * 32768 + l31 * 128;
            const int ksw = l31 & 7;
            float m = -INFINITY;
#pragma unroll 2
            for (int kb = 0; kb < 8; ++kb) {
                f32x16 acc;
#pragma unroll
                for (int r = 0; r < 16; ++r) acc[r] = 0.f;
#pragma unroll
                for (int s = 0; s < 4; ++s) { const f16x8 kfr = *(const LAS f16x8*)(kl + kb * 4096 + (((2 * s + hi) ^ ksw) << 4)); acc = __builtin_amdgcn_mfma_f32_32x32x16_f16(kfr, Qf[s], acc, 0, 0, 0); }
#pragma unroll
                for (int r = 0; r < 16; ++r) m = fmaxf(m, acc[r]);
            }
            m = fmaxf(m, __shfl_xor(m, 32));
            float sum = 0.f;
            f32x16 O[2];
#pragma unroll
            for (int db = 0; db < 2; ++db)
#pragma unroll
                for (int r = 0; r < 16; ++r) O[db][r] = 0.f;
            u32x4 va[2][2], vb2[2][2];
#define LOADV(dst, kb_) do { _Pragma("unroll") for (int s2 = 0; s2 < 2; ++s2) _Pragma("unroll") for (int db = 0; db < 2; ++db) { \
                const char* vp = vbase + (32 * db * NMEM + 32 * (kb_) + 16 * s2) * 2 + (size_t)voff; dst[s2][db] = *(const u32x4*)vp; } } while (0)
            LOADV(va, 0); LOADV(vb2, 1);
#pragma unroll 1
            for (int kb = 0; kb < 8; kb += 2) {
#pragma unroll
                for (int half2 = 0; half2 < 2; ++half2) {
                    const int kbb = kb + half2;
                    f32x16 acc;
#pragma unroll
                    for (int r = 0; r < 16; ++r) acc[r] = 0.f;
#pragma unroll
                    for (int s = 0; s < 4; ++s) { const f16x8 kfr = *(const LAS f16x8*)(kl + kbb * 4096 + (((2 * s + hi) ^ ksw) << 4)); acc = __builtin_amdgcn_mfma_f32_32x32x16_f16(kfr, Qf[s], acc, 0, 0, 0); }
#pragma unroll
                    for (int s2 = 0; s2 < 2; ++s2) {
                        f16x8 pf;
#pragma unroll
                        for (int j = 0; j < 8; ++j) { const float p = __builtin_amdgcn_exp2f((acc[8 * s2 + j] - m) * scl); sum += p; pf[j] = (f16)p; }
#pragma unroll
                        for (int db = 0; db < 2; ++db) {
                            const u32x4 vr = half2 ? vb2[s2][db] : va[s2][db];
                            const auto s0_ = __builtin_amdgcn_permlane32_swap(vr.x, vr.z, false, false), s1_ = __builtin_amdgcn_permlane32_swap(vr.y, vr.w, false, false);
                            u32x4 vq; vq.x = s0_[0]; vq.y = s1_[0]; vq.z = s0_[1]; vq.w = s1_[1];
                            const f16x8 vf = __builtin_bit_cast(f16x8, vq);
                            O[db] = __builtin_amdgcn_mfma_f32_32x32x16_f16(vf, pf, O[db], 0, 0, 0);
                        }
                    }
                    if (half2 == 0) { const int kn = (kb + 2 < 8) ? kb + 2 : 7; LOADV(va, kn); } else { const int kn = (kb + 3 < 8) ? kb + 3 : 7; LOADV(vb2, kn); }
                }
            }
#undef LOADV
            sum += __shfl_xor(sum, 32);
            const float inv = 1.f / sum;
            f16* orow = mixed + (size_t)(tok0 + 32 * th + l31) * D + DRNN + DPOOL + 64 * h + 4 * hi;
#pragma unroll
            for (int db = 0; db < 2; ++db)
#pragma unroll
                for (int rg = 0; rg < 4; ++rg) { u32x2 o; o.x = pk_f16(O[db][4 * rg] * inv, O[db][4 * rg + 1] * inv); o.y = pk_f16(O[db][4 * rg + 2] * inv, O[db][4 * rg + 3] * inv); *(u32x2*)(orow + 32 * db + 8 * rg) = o; }
        }
        asm volatile("s_waitcnt vmcnt(0)" ::: "memory");
        __syncthreads();
    }
}

__device__ __forceinline__ void p5_route(Frame& F) {
    const float* PARTL = (const float*)(F.ws + WS_PARTL); const float* SSQP = (const float*)(F.ws + WS_SSQP); const float* b_r = F.in[18];
    int* list = (int*)(F.ws + WS_LIST); float* glist = (float*)(F.ws + WS_GLIST); float* rlist = (float*)(F.ws + WS_RLIST);
    LAS float* lg = (LAS float*)(F.lds);
    LAS float* rs = (LAS float*)(F.lds + 8448);
    LAS int* sel_e = (LAS int*)(F.lds + 8704);
    LAS int* sel_r = (LAS int*)(F.lds + 9728);
    LAS float* sel_g = (LAS float*)(F.lds + 10752);
    LAS int* lcnt = (LAS int*)(F.lds + 11776);
    LAS int* lbase = (LAS int*)(F.lds + 11904);
    const int w = F.wave, lane = F.lane;
    for (int ch = F.bx; ch < T / 64; ch += F.G) {
        const int tok0 = ch * 64;
        if (F.tid < 32) lcnt[F.tid] = 0;
        {
            const int token = F.tid >> 3, e4 = (F.tid & 7) * 4;
            f32x4 sum = *(const f32x4*)(PARTL + (size_t)(tok0 + token) * 32 + e4); float ss = SSQP[tok0 + token];
#pragma unroll
            for (int pn = 1; pn < 4; ++pn) { sum += *(const f32x4*)(PARTL + ((size_t)pn * T + tok0 + token) * 32 + e4); ss += SSQP[(size_t)pn * T + tok0 + token]; }
            const float rstd = rsqrtf(ss * (1.f / D) + EPS);
            const f32x4 bb = *(const f32x4*)(b_r + e4);
#pragma unroll
            for (int j = 0; j < 4; ++j) lg[token * 33 + e4 + j] = sum[j] * (rstd * (1.f / 1024.f)) + bb[j];
            if ((F.tid & 7) == 0) rs[token] = rstd;
        }
        __syncthreads();
#pragma unroll 1
        for (int p = 0; p < 4; ++p) {
            const int token = 16 * p + 2 * w + (lane >> 5), le = lane & 31;
            float v = lg[token * 33 + le];
            int idx[4]; float val[4];
#pragma unroll
            for (int k = 0; k < 4; ++k) {
                float mx = v;
#pragma unroll
                for (int o = 1; o < 32; o <<= 1) mx = fmaxf(mx, __shfl_xor(mx, o));
                const unsigned long long bal = __ballot(v == mx);
                const unsigned half = (unsigned)(bal >> (lane & 32));
                const int bi = __builtin_ctz(half);
                idx[k] = bi; val[k] = mx;
                if (le == bi) v = -INFINITY;
            }
            if (le == 0) {
                float es[4], sum = 0.f;
#pragma unroll
                for (int k = 0; k < 4; ++k) { es[k] = __expf(val[k] - val[0]); sum += es[k]; }
                const float inv = 1.f / sum;
#pragma unroll
                for (int k = 0; k < 4; ++k) { const int sl = token * 4 + k; sel_e[sl] = idx[k]; sel_g[sl] = es[k] * inv; sel_r[sl] = atomicAdd((int*)&lcnt[idx[k]], 1); }
            }
        }
        __syncthreads();
        if (F.tid < 32) { const int n = lcnt[F.tid]; lbase[F.tid] = n ? (int)atomicAdd(&F.ctl[CW_COUNTS + 64 * F.tid], (unsigned)n) : 0; }
        __syncthreads();
        if (F.tid < 256) { const int e = sel_e[F.tid]; const int li = e * T + lbase[e] + sel_r[F.tid]; list[li] = (tok0 + (F.tid >> 2)) * 4 + (F.tid & 3); glist[li] = sel_g[F.tid]; rlist[li] = rs[F.tid >> 2]; }
        __syncthreads();
    }
}

__device__ __forceinline__ void p8_final(Frame& F) {
    const f16* x1 = (const f16*)(F.ws + WS_X1); const unsigned char* Y = F.ws + WS_Y; const float* g = F.in[23];
    float* out = (float*)F.out;
    const int gw = F.vcu * NWAVES + F.wave, NGW = F.G * NWAVES, lane = F.lane;
    const int per = (T + NGW - 1) / NGW;
    f32x4 gg[4];
#pragma unroll
    for (int j = 0; j < 4; ++j) gg[j] = ((const f32x4*)g)[lane + 64 * j];
    for (int t0 = gw * per; t0 < (gw + 1) * per && t0 < T; t0 += 4) {
        f16x4 xh[4][4]; int yv[4][4][4];
#pragma unroll
        for (int q = 0; q < 4; ++q) {
            const int tok = (t0 + q < T) ? t0 + q : T - 1;
#pragma unroll
            for (int j = 0; j < 4; ++j) {
                xh[q][j] = ((const f16x4*)(x1 + (size_t)tok * D))[lane + 64 * j];
#pragma unroll
                for (int k = 0; k < 4; ++k) yv[q][j][k] = __builtin_nontemporal_load((const int*)(Y + (size_t)(tok * 4 + k) * D + 4 * (lane + 64 * j)));
            }
        }
#pragma unroll
        for (int q = 0; q < 4; ++q) {
            f32x4 v[4]; float s = 0.f;
#pragma unroll
            for (int j = 0; j < 4; ++j) {
                f32x4 a = {(float)xh[q][j][0], (float)xh[q][j][1], (float)xh[q][j][2], (float)xh[q][j][3]};
#pragma unroll
                for (int k = 0; k < 4; ++k) { const f32x2 lo = __builtin_amdgcn_cvt_pk_f32_fp8(yv[q][j][k], false), hi2 = __builtin_amdgcn_cvt_pk_f32_fp8(yv[q][j][k], true);
                    a[0] += lo[0] * (1.f / SC_Y); a[1] += lo[1] * (1.f / SC_Y); a[2] += hi2[0] * (1.f / SC_Y); a[3] += hi2[1] * (1.f / SC_Y); }
                v[j] = a; s += (a[0] * a[0] + a[1] * a[1]) + (a[2] * a[2] + a[3] * a[3]);
            }
            s = wave_sum(s);
            const float r = rsqrtf(s * (1.f / D) + EPS);
            if (t0 + q < T && t0 + q < (gw + 1) * per) {
#pragma unroll
                for (int j = 0; j < 4; ++j) __builtin_nontemporal_store(v[j] * r * gg[j], (f32x4*)(out + (size_t)(t0 + q) * D) + lane + 64 * j);
            }
        }
    }
}

constexpr int NPHASE = 9;
__global__ void __launch_bounds__(NWAVES * 64, 2) mega(Params P) {
    extern __shared__ __attribute__((aligned(16))) unsigned char lds_raw[];
    Frame F;
    F.lds = (LAS unsigned char*)lds_raw;
    F.tid = threadIdx.x; F.lane = F.tid & 63; F.wave = __builtin_amdgcn_readfirstlane(F.tid >> 6);
    F.G = gridDim.x; F.bx = blockIdx.x; F.vcu = (F.G % 8 == 0) ? (F.bx % 8) * (F.G / 8) + F.bx / 8 : F.bx;
    F.ws = P.ws; F.ctl = (unsigned*)(P.ws + WS_CTL); F.in = P.in; F.out = P.out; F.flags = P.flags;
    for (int u = F.tid; u < (LDS_BYTES - LDS_CTL_OFF) / 4; u += NWAVES * 64) ((LAS unsigned*)(F.lds + LDS_CTL_OFF))[u] = 0u;
    __syncthreads();
    const int lo = P.ph_lo, hi = P.ph_hi;
    XcdBarrier bar; bar.bar = F.ctl + CW_BAR; bar.x = 0; bar.st = nullptr;
    if (hi - lo > 1) bar = xcd_barrier_post(F.ctl + CW_BAR, (volatile LAS unsigned*)(F.lds + LDS_CTL_OFF + 32));
#define IN(k) (lo <= (k) && (k) < hi)
#define SEAM(k) do { if (IN(k) && IN((k) + 1)) xcd_barrier(bar); } while (0)
    if (IN(0)) { p0_prologue(F); p0_small(F); SEAM(0); }
    if (IN(1)) {
        SchedP1 S{(const char*)(F.ws + WS_H0), (const char*)(F.ws + WS_WINT), (const char*)(F.ws + WS_MEMN), (const char*)(F.ws + WS_WKVT), F.G, F.bx};
        EpiP1 E{(f16*)(F.ws + WS_PROJ), (f16*)(F.ws + WS_KH), (f16*)(F.ws + WS_VT)};
        pg::gemm_phase(F.lds, S, E);
        p1_deferred_items(F);
        SEAM(1);
    }
    if (IN(2)) { p2_mixer(F); if (!IN(3)) {} }
    if (IN(3)) { SEAM(3); }
    if (IN(4)) {
        EpiP3 E{F.in[0], (f16*)(F.ws + WS_X1), F.ws + WS_X1N, F.in[16], (const f16*)(F.ws + WS_SMALLW + SW_WRP), (float*)(F.ws + WS_PARTL), (float*)(F.ws + WS_SSQP), F.lds};
        for (int L = F.bx; L < 64 * 4; L += F.G) { SchedP3 S{(const char*)(F.ws + WS_MIXED), (const char*)(F.ws + WS_WOUTT), L}; pg::gemm_phase(F.lds, S, E); }
        SEAM(4);
    }
    if (IN(5)) { p5_route(F); SEAM(5); }
    if (IN(6)) {
        moe_table(F);
        SchedMoe<8, true> S{(const char*)(F.ws + WS_X1N), (const char*)(F.ws + WS_WGUT), (size_t)2 * DFF * pg::ROWB8, (const int*)(F.ws + WS_LIST), (const LAS int*)(F.lds + LDS_CTL_OFF + 256), F.G, F.bx};
        EpiGU E{F.in[20], (const float*)(F.ws + WS_RLIST), (unsigned char*)(F.ws + WS_HBUF), F.flags & 1};
        pg::gemm_phase(F.lds, S, E);
        SEAM(6);
    }
    if (IN(7)) {
        moe_table(F);
        SchedMoe<4, false> S{(const char*)(F.ws + WS_HBUF), (const char*)(F.ws + WS_WDT), (size_t)D * pg::ROWB8, (const int*)(F.ws + WS_LIST), (const LAS int*)(F.lds + LDS_CTL_OFF + 256), F.G, F.bx};
        EpiDown E{F.in[22], (const int*)(F.ws + WS_LIST), (const float*)(F.ws + WS_GLIST), (unsigned char*)(F.ws + WS_Y), F.flags & 1};
        pg::gemm_phase(F.lds, S, E);
        SEAM(7);
    }
    if (IN(8)) { p8_final(F); }
#undef IN
#undef SEAM
}
}

extern "C" void kernel_launch(void* const* d_in, const int* in_sizes, int n_in, void* d_out, int out_size, void* d_ws, size_t ws_size, hipStream_t stream) {
    static int grid = 0;
    if (grid == 0) {
        if (n_in != 24 || ws_size < WS_END) { fprintf(stderr, "kernel_launch: unexpected n_in %d / ws %zu\n", n_in, ws_size); grid = -1; return; }
        int dev = 0, cus = 0;
        (void)hipGetDevice(&dev); (void)hipDeviceGetAttribute(&cus, hipDeviceAttributeMultiprocessorCount, dev);
        if (hipFuncSetAttribute((const void*)mega, hipFuncAttributeMaxDynamicSharedMemorySize, LDS_BYTES) != hipSuccess) { fprintf(stderr, "kernel_launch: hipFuncSetAttribute failed\n"); grid = -1; return; }
        int per_cu = 0;
        if (hipOccupancyMaxActiveBlocksPerMultiprocessor(&per_cu, (const void*)mega, NWAVES * 64, LDS_BYTES) != hipSuccess || per_cu < 1) fprintf(stderr, "kernel_launch: occupancy query says %d\n", per_cu);
        (void)hipGetLastError();
        grid = cus;
        if (grid % 8 != 0) fprintf(stderr, "kernel_launch: grid %d not a multiple of 8\n", grid);
    }
    if (grid < 0) return;
    unsigned char* ws = (unsigned char*)d_ws;
    (void)hipMemsetAsync(ws + WS_CTL, 0, 32768, stream);
    Params p{};
    for (int i = 0; i < 24; ++i) p.in[i] = (const float*)d_in[i];
    p.out = (float*)d_out; p.ws = ws;
    p.ph_lo = 0; p.ph_hi = NPHASE;
    hipLaunchKernelGGL(mega, dim3(grid), dim3(NWAVES * 64), LDS_BYTES, stream, p);
}
```

```cpp
#include <hip/hip_runtime.h>
#include <cstdio>
#include <cstdint>


namespace {
constexpr int BATCH = 2, SEQ = 8192, D = 1024, T = BATCH * SEQ, NMEM = 256;
constexpr int DRNN = 512, NH = 8, DPOOL = 256, DX = 256, XH = 4, DIN = 1536;
constexpr int NE = 32, TOPK = 4, DFF = 1024, TK = T * TOPK;
constexpr float EPS = 1e-6f;
typedef _Float16 f16;
typedef _Float16 f16x2 __attribute__((ext_vector_type(2)));
typedef _Float16 f16x4 __attribute__((ext_vector_type(4)));
typedef _Float16 f16x8 __attribute__((ext_vector_type(8)));
typedef float f32x2 __attribute__((ext_vector_type(2)));
typedef float f32x4 __attribute__((ext_vector_type(4)));
typedef unsigned u32x4 __attribute__((ext_vector_type(4)));
typedef unsigned u32x2 __attribute__((ext_vector_type(2)));
#define LAS __attribute__((address_space(3)))

constexpr size_t MiB = 1u << 20;
constexpr size_t WS_CTL = 0;
constexpr size_t WS_LIST = 1 * MiB;
constexpr size_t WS_TOPE = 3 * MiB;
constexpr size_t WS_TOPG = 3 * MiB + 512 * 1024;
constexpr size_t WS_SMALLW = 4 * MiB;
constexpr size_t WS_WKVT = 5 * MiB;
constexpr size_t WS_MEMN = 6 * MiB;
constexpr size_t WS_KH = 7 * MiB;
constexpr size_t WS_VT = 7 * MiB + 512 * 1024;
constexpr size_t WS_WINT = 8 * MiB;
constexpr size_t WS_WOUTT = 11 * MiB;
constexpr size_t WS_AGG = 13 * MiB;
constexpr size_t WS_KVF = 14 * MiB;
constexpr size_t WS_GLIST = 14 * MiB;
constexpr size_t WS_WGUT = 16 * MiB;
constexpr size_t WS_WDT = 144 * MiB;
constexpr size_t WS_H0 = 208 * MiB;
constexpr size_t WS_PROJ = 240 * MiB;
constexpr size_t WS_PARTL = 288 * MiB;
constexpr size_t WS_SSQP = 296 * MiB;
constexpr size_t WS_RLIST = 297 * MiB;
constexpr size_t WS_MIXED = 352 * MiB;
constexpr size_t WS_X1 = 384 * MiB;
constexpr size_t WS_X1N = 448 * MiB;
constexpr size_t WS_HBUF = 482 * MiB;
constexpr size_t WS_Y = 626 * MiB;
constexpr size_t WS_END = 756 * MiB;
constexpr int CW_COUNTS = 0;
constexpr int CW_BAR = 4096;

struct Params {
    const float* in[24];
    float* out;
    unsigned char* ws;
    int ph_lo, ph_hi, flags, pad;
};

__device__ __forceinline__ float wave_sum(float v) {
#pragma unroll
    for (int o = 1; o < 64; o <<= 1) v += __shfl_xor(v, o);
    return v;
}
__device__ __forceinline__ float sigmoidf_(float x) { return 1.f / (1.f + expf(-x)); }
__device__ __forceinline__ unsigned pk_f16(float lo, float hi) { f32x2 v = {lo, hi}; f16x2 h = __builtin_convertvector(v, f16x2); return __builtin_bit_cast(unsigned, h); }
constexpr float SC_W = 64.f, SC_X = 16.f, SC_H = 4.f, SC_Y = 16.f;
__device__ __forceinline__ unsigned pk4_fp8(float a, float b, float c, float d) { int r = __builtin_amdgcn_cvt_pk_fp8_f32(a, b, 0, false); r = __builtin_amdgcn_cvt_pk_fp8_f32(c, d, r, true); return (unsigned)r; }
__device__ __forceinline__ float4 load4(const float* p) { return *(const float4*)p; }
__device__ __forceinline__ float4 load4(const f16* p) { const f16x4 h = *(const f16x4*)p; return make_float4((float)h[0], (float)h[1], (float)h[2], (float)h[3]); }
__device__ __forceinline__ void store4(float* p, float4 v) { *(float4*)p = v; }
__device__ __forceinline__ void store4(f16* p, float4 v) { u32x2 w; w.x = pk_f16(v.x, v.y); w.y = pk_f16(v.z, v.w); *(u32x2*)p = w; }
__device__ __forceinline__ int gu_dest_row(int n) { return n < DFF ? ((n >> 7) * 256 + (n & 127)) : (((n - DFF) >> 7) * 256 + 128 + ((n - DFF) & 127)); }

namespace pg {
constexpr int LDS_EPI = 139264 + 8192;
constexpr int LDS_PF_OFF = 139264 + 4096;
constexpr int BM = 256, BK = 64, HALF = 128, HTB = HALF * BK * 2, STAGE_BYTES = 8 * HTB, KD = 1024, NT = KD / BK;
constexpr unsigned ROWB = KD * 2;
constexpr unsigned ROWB8 = KD;
typedef int i32x8 __attribute__((ext_vector_type(8)));
__host__ __device__ __forceinline__ int lds_byte(int r, int c) { const int st = (r >> 4) * 2 + (c >> 5), rr = r & 15, cc = c & 31, ob = rr * 64 + cc * 2; return st * 1024 + (ob ^ (((ob >> 9) & 1) << 5)); }
__host__ __device__ __forceinline__ void stage_rc(int b, int& R, int& C) { const int st = b / 1024, sb = b % 1024, swz = sb ^ (((sb >> 9) & 1) << 5); R = (st >> 1) * 16 + swz / 64; C = (st & 1) * 32 + (swz % 64) / 2; }
__host__ __device__ __forceinline__ int perm32(int rho) { const int n = rho >> 4, i = rho & 15; return 8 * (i >> 2) + 4 * n + (i & 3); }

struct Unit { const char* A; const char* B; int kind, pm, pn, e, p0, cnt, hrow; };

__device__ __forceinline__ void glds16(const void* sbase, unsigned voff, unsigned lds_dst) {
    unsigned keep;
    asm volatile("s_mov_b32 %0, m0\n\ts_mov_b32 m0, %3\n\ts_nop 0\n\tglobal_load_lds_dwordx4 %1, %2\n\ts_mov_b32 m0, %0"
                 : "=&s"(keep) : "v"(voff), "s"(sbase), "s"(lds_dst) : "memory");
}
__device__ __forceinline__ const char* uptr(const char* p) {
    const unsigned long long v = (unsigned long long)(size_t)p;
    const unsigned lo = __builtin_amdgcn_readfirstlane((unsigned)v), hi = __builtin_amdgcn_readfirstlane((unsigned)(v >> 32));
    return (const char*)(size_t)(((unsigned long long)hi << 32) | lo);
}
__device__ __forceinline__ void glds4_prefetch(const void* sbase, unsigned voff, unsigned lds_dst) {
    unsigned keep;
    asm volatile("s_nop 4\n\ts_mov_b32 %0, m0\n\ts_mov_b32 m0, %3\n\ts_nop 0\n\tglobal_load_lds_dword %1, %2\n\ts_mov_b32 m0, %0"
                 : "=&s"(keep) : "v"(voff), "s"(sbase), "s"(lds_dst) : "memory");
}
__device__ __forceinline__ void glds16n(const void* sbase, unsigned voff, unsigned lds_dst) {
    unsigned keep;
    asm volatile("s_nop 4\n\ts_mov_b32 %0, m0\n\ts_mov_b32 m0, %3\n\ts_nop 0\n\tglobal_load_lds_dwordx4 %1, %2\n\ts_mov_b32 m0, %0"
                 : "=&s"(keep) : "v"(voff), "s"(sbase), "s"(lds_dst) : "memory");
}
template <class Sched, class Epi>
__device__ __forceinline__ void gemm_phase(LAS unsigned char* lds, const Sched& S, const Epi& E) {
    constexpr bool FP8 = Epi::FP8, GATHER = Sched::GATHER;
    constexpr unsigned ROWB_ = FP8 ? ROWB8 : ROWB;
    constexpr int NT_ = FP8 ? (KD / 128) : (KD / BK);
    const int tid = threadIdx.x, wid = __builtin_amdgcn_readfirstlane(tid >> 6), lane = tid & 63, wr = wid >> 2, wc = wid & 3, fr = lane & 15, fq = lane >> 4;
    int R0, C0; stage_rc(tid * 16, R0, C0);
    const unsigned colb = (unsigned)C0 * 2u;
    const unsigned voffA0 = (unsigned)R0 * ROWB_ + colb;
    const unsigned voffB0 = (unsigned)(Epi::PERM ? ((R0 & ~31) + perm32(R0 & 31)) : R0) * ROWB_ + colb;
    unsigned arow[4], arowN[4];
    const size_t kstep = (size_t)(BK * 2);
    const size_t hstepB = (size_t)HALF * ROWB_, qstep = (size_t)64 * ROWB_;
    const unsigned ldsb = (unsigned)(size_t)lds + (unsigned)wid * 1024u;
    const int aoff = lds_byte(wr * 64 + fr, fq * 8), boff = lds_byte(wc * 32 + fr, fq * 8);
#define PG_SA(b, h) (((b) * 2 + (h)) * HTB)
#define PG_SB(b, h) ((4 + (b) * 2 + (h)) * HTB)
#define PG_STAGEB(bufoff, gbase) do { glds16((const char*)(gbase), voffB0, ldsb + (bufoff)); glds16((const char*)(gbase) + qstep, voffB0, ldsb + (bufoff) + 8192); } while (0)
#define PG_STAGEA(bufoff, gbase, r0_, r1_, h) do { \
        if constexpr (GATHER) { glds16((const char*)(gbase), (r0_), ldsb + (bufoff)); glds16((const char*)(gbase), (r1_), ldsb + (bufoff) + 8192); } \
        else { glds16((const char*)(gbase) + (2 * (h)) * qstep, voffA0, ldsb + (bufoff)); glds16((const char*)(gbase) + (2 * (h) + 1) * qstep, voffA0, ldsb + (bufoff) + 8192); } } while (0)
#define PG_LDA(dst, b, h) do { _Pragma("unroll") for (int m = 0; m < 4; ++m) { \
        if constexpr (FP8) { const u32x4 lo_ = *(const LAS u32x4*)(lds + PG_SA(b, h) + aoff + m * 2048), hi_ = *(const LAS u32x4*)(lds + PG_SA(b, h) + aoff + m * 2048 + 1024); dst##8[m] = __builtin_shufflevector(lo_, hi_, 0, 1, 2, 3, 4, 5, 6, 7); } \
        else { _Pragma("unroll") for (int k = 0; k < 2; ++k) dst[m][k] = *(const LAS f16x8*)(lds + PG_SA(b, h) + aoff + m * 2048 + k * 1024); } } } while (0)
#define PG_LDB(dst, b, h) do { _Pragma("unroll") for (int n = 0; n < 2; ++n) { \
        if constexpr (FP8) { const u32x4 lo_ = *(const LAS u32x4*)(lds + PG_SB(b, h) + boff + n * 2048), hi_ = *(const LAS u32x4*)(lds + PG_SB(b, h) + boff + n * 2048 + 1024); dst##8[n] = __builtin_shufflevector(lo_, hi_, 0, 1, 2, 3, 4, 5, 6, 7); } \
        else { _Pragma("unroll") for (int k = 0; k < 2; ++k) dst[n][k] = *(const LAS f16x8*)(lds + PG_SB(b, h) + boff + n * 2048 + k * 1024); } } } while (0)
#define PG_MMA(ai, bj, At, Bt) do { __builtin_amdgcn_s_setprio(1); _Pragma("unroll") for (int m = 0; m < 4; ++m) _Pragma("unroll") for (int n = 0; n < 2; ++n) { \
        if constexpr (FP8) asm volatile("v_mfma_scale_f32_16x16x128_f8f6f4 %0, %1, %2, %0, %3, %3 op_sel_hi:[0,0,0]" : "+v"(acc[ai][bj][m][n]) : "v"(Bt##8[n]), "v"(At##8[m]), "v"(mxscale)); \
        else { _Pragma("unroll") for (int k = 0; k < 2; ++k) acc[ai][bj][m][n] = __builtin_amdgcn_mfma_f32_16x16x32_f16(Bt[n][k], At[m][k], acc[ai][bj][m][n], 0, 0, 0); } } \
        __builtin_amdgcn_s_setprio(0); } while (0)
#define PG_WAIT_V(n) asm volatile("s_waitcnt vmcnt(" #n ")" ::: "memory")
#define PG_WAIT_L(n) asm volatile("s_waitcnt lgkmcnt(" #n ")" ::: "memory")
#define PG_BAR __builtin_amdgcn_s_barrier()
#define PG_SCHED __builtin_amdgcn_sched_barrier(0)
    Unit cur, nxt; int ui = 0;
    if (!S.next(0, cur)) return;
    if constexpr (GATHER) S.rows(cur, R0, colb, arow);
    f32x4 acc[2][2][4][2];
    f16x8 At[4][2], B0[2][2], B1[2][2];
    typedef unsigned u32x8 __attribute__((ext_vector_type(8)));
    u32x8 At8[4], B08[2], B18[2];
    unsigned mxscale = 0x7F7F7F7Fu; asm volatile("" : "+v"(mxscale));
    const char* cA = cur.A; const char* cB = cur.B;
    PG_WAIT_V(0);
    E.init(acc, cur, wr, wc, fr, fq);
    E.prefetch(cur, wid, lane, (unsigned)(size_t)lds + (unsigned)LDS_EPI);
    PG_STAGEB(PG_SB(0, 0), cB); PG_STAGEB(PG_SB(0, 1), cB + hstepB); PG_STAGEA(PG_SA(0, 0), cA, arow[0], arow[1], 0); PG_STAGEA(PG_SA(0, 1), cA, arow[2], arow[3], 1);
    if (wr == 1) PG_BAR;
    PG_WAIT_V(2); PG_BAR;
    PG_STAGEB(PG_SB(1, 0), cB + kstep); PG_STAGEA(PG_SA(1, 0), cA + kstep, arow[0], arow[1], 0); PG_STAGEB(PG_SB(1, 1), cB + hstepB + kstep);
    PG_WAIT_V(6); PG_BAR;
#pragma unroll
    for (int a = 0; a < 2; ++a)
#pragma unroll
        for (int b = 0; b < 2; ++b)
            asm volatile("" : "+v"(acc[a][b][0][0]), "+v"(acc[a][b][0][1]), "+v"(acc[a][b][1][0]), "+v"(acc[a][b][1][1]), "+v"(acc[a][b][2][0]), "+v"(acc[a][b][2][1]), "+v"(acc[a][b][3][0]), "+v"(acc[a][b][3][1]));
    for (;;) {
        const bool has_next = S.next(ui + 1, nxt);
        const char* nA = has_next ? nxt.A : cA; const char* nB = has_next ? nxt.B : cB;
        const int hf_ = Sched::HALVES ? __builtin_amdgcn_readfirstlane(cur.kind) : 0;
        unsigned rawN[4];
        if constexpr (GATHER) {
            if (has_next) S.rows_issue(nxt, R0, rawN);
            else {
#pragma unroll
                for (int q = 0; q < 4; ++q) arowN[q] = arow[q];
            }
        }
#pragma unroll 1
        for (int t = 0; t < NT_; t += 2) {
            const bool last = (t == NT_ - 2);
            if (t == 2 && has_next) E.prefetch(nxt, wid, lane, (unsigned)(size_t)lds + (unsigned)LDS_EPI + (unsigned)(((ui + 1) & 1) * 4096));
            if constexpr (GATHER) {
                if (last && has_next) {
                    asm volatile("s_waitcnt vmcnt(8)" : "+v"(rawN[0]), "+v"(rawN[1]), "+v"(rawN[2]), "+v"(rawN[3]) :: "memory");
                    S.rows_finish(nxt, R0, colb, rawN, arowN);
                }
            }
            const char* a1 = cA + (size_t)(t + 1) * kstep;
            const char* a2 = last ? nA : cA + (size_t)(t + 2) * kstep; const char* b2 = last ? nB : cB + (size_t)(t + 2) * kstep;
            const char* a3 = a2 + kstep; const char* b3 = b2 + kstep;
            PG_LDB(B0, 0, 0); PG_LDB(B1, 0, 1); PG_SCHED; PG_LDA(At, 0, 0); PG_STAGEA(PG_SA(1, 1), a1, arow[2], arow[3], 1);
            PG_WAIT_V(8); PG_WAIT_L(0); PG_BAR; if (!Sched::HALVES || hf_ != 2) { PG_MMA(0, 0, At, B0); PG_MMA(0, 1, At, B1); } PG_BAR; PG_SCHED;
            PG_LDA(At, 0, 1); PG_STAGEB(PG_SB(0, 0), b2); PG_STAGEB(PG_SB(0, 1), b2 + hstepB); PG_STAGEA(PG_SA(0, 0), a2, (last ? arowN[0] : arow[0]), (last ? arowN[1] : arow[1]), 0);
            PG_WAIT_V(8); PG_WAIT_L(0); PG_BAR; if (!Sched::HALVES || hf_ != 1) { PG_MMA(1, 0, At, B0); PG_MMA(1, 1, At, B1); } PG_BAR; PG_SCHED;
            PG_LDB(B0, 1, 0); PG_LDB(B1, 1, 1); PG_SCHED; PG_LDA(At, 1, 0); PG_STAGEA(PG_SA(0, 1), a2, (last ? arowN[2] : arow[2]), (last ? arowN[3] : arow[3]), 1);
            PG_WAIT_V(8); PG_WAIT_L(0); PG_BAR; if (!Sched::HALVES || hf_ != 2) { PG_MMA(0, 0, At, B0); PG_MMA(0, 1, At, B1); } PG_BAR; PG_SCHED;
            PG_LDA(At, 1, 1); PG_STAGEB(PG_SB(1, 0), b3); PG_STAGEB(PG_SB(1, 1), b3 + hstepB); PG_STAGEA(PG_SA(1, 0), a3, (last ? arowN[0] : arow[0]), (last ? arowN[1] : arow[1]), 0);
            PG_WAIT_V(8); PG_WAIT_L(0); PG_BAR; if (!Sched::HALVES || hf_ != 1) { PG_MMA(1, 0, At, B0); PG_MMA(1, 1, At, B1); } PG_BAR; PG_SCHED;
        }
        if constexpr (Sched::PREFETCH) {
            if (has_next) {
                const unsigned pf_lds = (unsigned)(size_t)lds + (unsigned)(LDS_PF_OFF) + (unsigned)wid * 256u;
                if constexpr (GATHER) { if ((wid & 1) == 0) { const unsigned q = (unsigned)lane & 3u; const unsigned ro = (q == 0 ? arowN[0] : q == 1 ? arowN[1] : q == 2 ? arowN[2] : arowN[3]) - colb; glds4_prefetch(uptr(nA + 128 * nxt.pn), ro, pf_lds); } }
                else { const unsigned t_ = (unsigned)tid & 255u, k_ = (unsigned)(2 * nxt.pn) + ((unsigned)tid >> 8); glds4_prefetch(uptr(nA), t_ * ROWB_ + 128u * k_, pf_lds); }
            }
        }
        if (wr == 0) PG_BAR;
        if constexpr (FP8) asm volatile("s_nop 15\n\ts_nop 15" ::: "memory");
        E(acc, cur, wr, wc, fr, fq, lds + LDS_EPI + (ui & 1) * 4096);
        if (!has_next) break;
        E.init(acc, nxt, wr, wc, fr, fq);
        cur = nxt; cA = nA; cB = nB; ++ui;
        if constexpr (GATHER) {
#pragma unroll
            for (int q = 0; q < 4; ++q) arow[q] = arowN[q];
        }
        if (wr == 1) PG_BAR;
    }
    PG_WAIT_V(0);
    PG_BAR;
#undef PG_SA
#undef PG_SB
#undef PG_STAGEA
#undef PG_STAGEB
#undef PG_LDA
#undef PG_LDB
#undef PG_MMA
#undef PG_WAIT_V
#undef PG_WAIT_L
#undef PG_BAR
#undef PG_SCHED
}

__device__ __forceinline__ void zero_acc(f32x4 (&acc)[2][2][4][2]) {
#pragma unroll
    for (int a = 0; a < 2; ++a)
#pragma unroll
        for (int b = 0; b < 2; ++b)
#pragma unroll
            for (int m = 0; m < 4; ++m)
#pragma unroll
                for (int n = 0; n < 2; ++n) acc[a][b][m][n] = (f32x4){0.f, 0.f, 0.f, 0.f};
}
template <unsigned RB = ROWB> __device__ __forceinline__ void dense_rows(int R0, unsigned colb, unsigned (&ar)[4]) {
#pragma unroll
    for (int q = 0; q < 4; ++q) ar[q] = (unsigned)(R0 + 64 * q) * RB + colb;
}
}

constexpr int NWAVES = 8;
constexpr int RING_BYTES = 131072;
constexpr int LDS_CTL_OFF = 139264;
constexpr int LDS_EPI_OFF = LDS_CTL_OFF + 8192;
constexpr int LDS_BYTES = 163840;

#define XB_TMO      128
#define XB_XCNT(j)  (256  + 64 * (j))
#define XB_XSUB(j)  (1280 + 64 * (j))
#define XB_XGEN(j)  (2304 + 64 * (j))
#define XB_TOP      3328
#define XB_TOPGEN   3392
#define XCD_BAR_WORDS 3456
#define XB_SPIN_CAP (1u << 18)
__device__ __forceinline__ unsigned xb_ld(unsigned* p)              { return __hip_atomic_load(p, __ATOMIC_RELAXED, __HIP_MEMORY_SCOPE_AGENT); }
__device__ __forceinline__ unsigned xb_add(unsigned* p, unsigned v) { return __hip_atomic_fetch_add(p, v, __ATOMIC_RELAXED, __HIP_MEMORY_SCOPE_AGENT); }
__device__ __forceinline__ unsigned xb_xcc_id() { return (unsigned)__builtin_amdgcn_s_getreg((3 << 11) | 20) & 0xFu; }
#define XB_SPIN(cond, bar) do { unsigned _sp = 0; while (cond) { __builtin_amdgcn_s_sleep(1); \
    if ((++_sp & 255u) == 0u) { if (xb_ld(&(bar)[XB_TMO])) break; if (_sp > XB_SPIN_CAP) { atomicAdd(&(bar)[XB_TMO], 1u); break; } } } } while (0)
struct XcdBarrier { unsigned* bar; unsigned x; volatile LAS unsigned* st; };
__device__ __forceinline__ XcdBarrier xcd_barrier_post(unsigned* bar, volatile LAS unsigned* st) {
    XcdBarrier b; b.bar = bar; b.x = xb_xcc_id(); b.st = st;
    if (threadIdx.x == 0) (void)xb_add(&bar[XB_XCNT(b.x)], 1u);
    return b;
}
__device__ __forceinline__ void xcd_barrier_complete(unsigned* bar, unsigned x, unsigned& nloc, unsigned& nx) {
    const unsigned G = gridDim.x * gridDim.y * gridDim.z;
    unsigned sum, cnt, mine, sp = 0u;
    for (;;) {
        sum = 0u; cnt = 0u; mine = 0u;
#pragma unroll
        for (unsigned j = 0; j < 16; ++j) { const unsigned c = xb_ld(&bar[XB_XCNT(j)]); sum += c; cnt += (c > 0u) ? 1u : 0u; mine = (j == x) ? c : mine; }
        if (sum == G) break;
        __builtin_amdgcn_s_sleep(1);
        if ((++sp & 255u) == 0u) { if (xb_ld(&bar[XB_TMO])) break; if (sp > XB_SPIN_CAP) { atomicAdd(&bar[XB_TMO], 1u); break; } }
    }
    nloc = mine > 0u ? mine : 1u; nx = cnt > 0u ? cnt : 1u;
}
__device__ __forceinline__ void xcd_barrier(const XcdBarrier& b) {
    asm volatile("s_waitcnt vmcnt(0)" ::: "memory");
    __syncthreads();
    if (threadIdx.x == 0) {
        unsigned* bar = b.bar;
        __builtin_amdgcn_s_waitcnt(0);
        unsigned nloc = b.st[0], nx = b.st[1];
        if (nloc == 0u) { xcd_barrier_complete(bar, b.x, nloc, nx); b.st[0] = nloc; b.st[1] = nx; }
        const unsigned old = xb_add(&bar[XB_XSUB(b.x)], 1u);
        const unsigned gen = old / nloc;
        if (old + 1u == (gen + 1u) * nloc) {
            __builtin_amdgcn_fence(__ATOMIC_RELEASE, "agent");
            asm volatile("s_waitcnt vmcnt(0)" ::: "memory");
            const unsigned og = xb_add(&bar[XB_TOP], 1u);
            const unsigned tg = og / nx;
            if (og + 1u == (tg + 1u) * nx) xb_add(&bar[XB_TOPGEN], 1u);
            else XB_SPIN(xb_ld(&bar[XB_TOPGEN]) == tg, bar);
            __builtin_amdgcn_fence(__ATOMIC_ACQUIRE, "agent");
            xb_add(&bar[XB_XGEN(b.x)], 1u);
            asm volatile("s_waitcnt vmcnt(0)" ::: "memory");
        } else {
            XB_SPIN(xb_ld(&bar[XB_XGEN(b.x)]) == gen, bar);
            __builtin_amdgcn_fence(__ATOMIC_ACQUIRE, "agent");
            asm volatile("s_waitcnt vmcnt(0)" ::: "memory");
        }
    }
    __syncthreads();
}

struct Frame {
    LAS unsigned char* lds;
    unsigned* ctl;
    unsigned char* ws;
    int tid, lane, wave, vcu, G, bx;
    const float* const* in;
    float* out;
    int flags;
};

__device__ __forceinline__ void p0_transpose_item(const float* __restrict__ src, int ld, int k0, int n0, f16* __restrict__ dst, int drow0, LAS unsigned* scr, int lane) {
    const int n4 = lane & 15, rr = lane >> 4;
    const float* s0 = src + (size_t)(k0 + 2 * rr) * ld + n0 + 4 * n4;
#pragma unroll 4
    for (int it = 0; it < 16; ++it) {
        const float4 v0 = *(const float4*)(s0 + (size_t)(8 * it) * ld);
        const float4 v1 = *(const float4*)(s0 + (size_t)(8 * it + 1) * ld);
        const int kp = it * 4 + rr;
        scr[(4 * n4 + 0) * 65 + kp] = pk_f16(v0.x, v1.x);
        scr[(4 * n4 + 1) * 65 + kp] = pk_f16(v0.y, v1.y);
        scr[(4 * n4 + 2) * 65 + kp] = pk_f16(v0.z, v1.z);
        scr[(4 * n4 + 3) * 65 + kp] = pk_f16(v0.w, v1.w);
    }
    asm volatile("s_waitcnt lgkmcnt(0)" ::: "memory");
    const int c = lane & 15, nl = lane >> 4;
#pragma unroll 4
    for (int jt = 0; jt < 16; ++jt) {
        const int n = jt * 4 + nl;
        u32x4 o; o.x = scr[n * 65 + 4 * c + 0]; o.y = scr[n * 65 + 4 * c + 1]; o.z = scr[n * 65 + 4 * c + 2]; o.w = scr[n * 65 + 4 * c + 3];
        *(u32x4*)(dst + (size_t)(drow0 + n) * 1024 + k0 + 8 * c) = o;
    }
    asm volatile("s_waitcnt lgkmcnt(0)" ::: "memory");
}
__device__ __forceinline__ void p0_transpose_item_fp8(const float* __restrict__ src, int ld, int k0, int n0, unsigned char* __restrict__ dst, int drow0, float sc, LAS unsigned* scr, int lane) {
    const int n4 = lane & 15, rr = lane >> 4;
    const float* s0 = src + (size_t)(k0 + 4 * rr) * ld + n0 + 4 * n4;
#pragma unroll 4
    for (int it = 0; it < 16; ++it) {
        const float* sp = s0 + (size_t)(16 * it) * ld;
        typedef float f4nt __attribute__((ext_vector_type(4)));
        const f4nt n0_ = __builtin_nontemporal_load((const f4nt*)(sp)), n1_ = __builtin_nontemporal_load((const f4nt*)(sp + ld)), n2_ = __builtin_nontemporal_load((const f4nt*)(sp + 2 * (size_t)ld)), n3_ = __builtin_nontemporal_load((const f4nt*)(sp + 3 * (size_t)ld));
        const float4 v0 = {n0_[0], n0_[1], n0_[2], n0_[3]}, v1 = {n1_[0], n1_[1], n1_[2], n1_[3]}, v2 = {n2_[0], n2_[1], n2_[2], n2_[3]}, v3 = {n3_[0], n3_[1], n3_[2], n3_[3]};
        const int kq = it * 4 + rr;
        scr[(4 * n4 + 0) * 65 + kq] = pk4_fp8(v0.x * sc, v1.x * sc, v2.x * sc, v3.x * sc);
        scr[(4 * n4 + 1) * 65 + kq] = pk4_fp8(v0.y * sc, v1.y * sc, v2.y * sc, v3.y * sc);
        scr[(4 * n4 + 2) * 65 + kq] = pk4_fp8(v0.z * sc, v1.z * sc, v2.z * sc, v3.z * sc);
        scr[(4 * n4 + 3) * 65 + kq] = pk4_fp8(v0.w * sc, v1.w * sc, v2.w * sc, v3.w * sc);
    }
    asm volatile("s_waitcnt lgkmcnt(0)" ::: "memory");
    const int c = lane & 15, nl = lane >> 4;
#pragma unroll 4
    for (int jt = 0; jt < 16; ++jt) {
        const int n = jt * 4 + nl;
        u32x4 o; o.x = scr[n * 65 + 4 * c + 0]; o.y = scr[n * 65 + 4 * c + 1]; o.z = scr[n * 65 + 4 * c + 2]; o.w = scr[n * 65 + 4 * c + 3];
        __builtin_nontemporal_store(o, (u32x4*)(dst + (size_t)(drow0 + n) * 1024 + k0 + 16 * c));
    }
    asm volatile("s_waitcnt lgkmcnt(0)" ::: "memory");
}
__device__ __forceinline__ void rms_row_f16(const float* __restrict__ xrow, const float* __restrict__ g, f16* __restrict__ orow, int lane) {
    const f32x4* xr = (const f32x4*)xrow + lane;
    f32x4 v[4]; float s = 0.f;
#pragma unroll
    for (int j = 0; j < 4; ++j) { v[j] = __builtin_nontemporal_load(xr + 64 * j); s += (v[j].x * v[j].x + v[j].y * v[j].y) + (v[j].z * v[j].z + v[j].w * v[j].w); }
    const float rstd = rsqrtf(wave_sum(s) * (1.f / D) + EPS);
    u32x2* o8 = (u32x2*)orow + lane;
#pragma unroll
    for (int j = 0; j < 4; ++j) { const f32x4 gg = ((const f32x4*)g)[lane + 64 * j]; u32x2 w; w.x = pk_f16(v[j].x * rstd * gg.x, v[j].y * rstd * gg.y); w.y = pk_f16(v[j].z * rstd * gg.z, v[j].w * rstd * gg.w); o8[64 * j] = w; }
}
constexpr int P0_IGU = NE * 4 * (2 * DFF / 64), P0_IDN = NE * 4 * (D / 64), P0_IEXP = P0_IGU + P0_IDN;
constexpr int P1_NGEMM = 128;
constexpr int P1_IDLE0 = P1_NGEMM + 4;
constexpr int P1_ITEMS_PER_WAVE = 4;
constexpr int P0_DEFER = (256 - P1_IDLE0) * 8 * P1_ITEMS_PER_WAVE;
__device__ __forceinline__ void p0_expert_item(Frame& F, int r, LAS unsigned* scr) {
    const float* w_gu = F.in[19]; const float* w_down = F.in[21];
    unsigned char* WguT = F.ws + WS_WGUT; unsigned char* WdT = F.ws + WS_WDT;
    if (r < P0_IGU) { const int e = r / (4 * 32), q = r % (4 * 32), nb = q & 31, kb = q >> 5;
        p0_transpose_item_fp8(w_gu + (size_t)e * D * 2 * DFF, 2 * DFF, kb * 256, nb * 64, WguT + (size_t)e * 2 * DFF * 1024, gu_dest_row(nb * 64), SC_W, scr, F.lane); }
    else { r -= P0_IGU; const int e = r / (4 * 16), q = r % (4 * 16), nb = q & 15, kb = q >> 4; p0_transpose_item_fp8(w_down + (size_t)e * DFF * D, D, kb * 256, nb * 64, WdT + (size_t)e * D * 1024, nb * 64, SC_W, scr, F.lane); }
}
typedef float f4nt __attribute__((ext_vector_type(4)));
struct ExpItem { const float* s0; size_t ld; unsigned char* dst; };
__device__ __forceinline__ ExpItem exp_item(Frame& F, int r) {
    const float* w_gu = F.in[19]; const float* w_down = F.in[21];
    const int n4 = F.lane & 15, rr = F.lane >> 4;
    ExpItem I;
    if (r < P0_IGU) { const int e = r / (4 * 32), q = r % (4 * 32), nb = q & 31, kb = q >> 5;
        I.ld = 2 * DFF; I.s0 = w_gu + (size_t)e * D * 2 * DFF + (size_t)(kb * 256 + 4 * rr) * (2 * DFF) + nb * 64 + 4 * n4; I.dst = F.ws + WS_WGUT + (size_t)e * 2 * DFF * 1024 + (size_t)gu_dest_row(nb * 64) * 1024 + kb * 256; }
    else { r -= P0_IGU; const int e = r / (4 * 16), q = r % (4 * 16), nb = q & 15, kb = q >> 4;
        I.ld = D; I.s0 = w_down + (size_t)e * DFF * D + (size_t)(kb * 256 + 4 * rr) * D + nb * 64 + 4 * n4; I.dst = F.ws + WS_WDT + (size_t)e * D * 1024 + (size_t)(nb * 64) * 1024 + kb * 256; }
    return I;
}
__device__ __forceinline__ void exp_issue(const ExpItem& I, int b, f4nt (&buf)[16]) {
#pragma unroll
    for (int i = 0; i < 4; ++i) { const float* sp = I.s0 + (size_t)(16 * (4 * b + i)) * I.ld;
#pragma unroll
        for (int j = 0; j < 4; ++j) buf[4 * i + j] = __builtin_nontemporal_load((const f4nt*)(sp + j * I.ld)); }
}
__device__ __forceinline__ void exp_consume(const f4nt (&buf)[16], int b, LAS unsigned* scr, int lane) {
    const int n4 = lane & 15, rr = lane >> 4;
#pragma unroll
    for (int i = 0; i < 4; ++i) { const int kq = (4 * b + i) * 4 + rr;
#pragma unroll
        for (int c = 0; c < 4; ++c) scr[(4 * n4 + c) * 65 + kq] = pk4_fp8(buf[4 * i][c] * SC_W, buf[4 * i + 1][c] * SC_W, buf[4 * i + 2][c] * SC_W, buf[4 * i + 3][c] * SC_W); }
}
__device__ __forceinline__ void exp_flush(const ExpItem& I, LAS unsigned* scr, int lane) {
    asm volatile("s_waitcnt lgkmcnt(0)" ::: "memory");
    const int c = lane & 15, nl = lane >> 4;
#pragma unroll 4
    for (int jt = 0; jt < 16; ++jt) {
        const int n = jt * 4 + nl;
        u32x4 o; o.x = scr[n * 65 + 4 * c + 0]; o.y = scr[n * 65 + 4 * c + 1]; o.z = scr[n * 65 + 4 * c + 2]; o.w = scr[n * 65 + 4 * c + 3];
        __builtin_nontemporal_store(o, (u32x4*)(I.dst + (size_t)n * 1024 + 16 * c));
    }
    asm volatile("s_waitcnt lgkmcnt(0)" ::: "memory");
}
__device__ __forceinline__ void p0_expert_run(Frame& F, int base, int start, int stride, int end, LAS unsigned* scr) {
    int it = start;
    if (it >= end) return;
    ExpItem cur = exp_item(F, base + it), nxt = cur;
    f4nt A[16], B[16];
    exp_issue(cur, 0, A);
    for (;;) {
        const int itn = it + stride; const bool has = itn < end;
        if (has) nxt = exp_item(F, base + itn);
        exp_issue(cur, 1, B); exp_consume(A, 0, scr, F.lane);
        exp_issue(cur, 2, A); exp_consume(B, 1, scr, F.lane);
        exp_issue(cur, 3, B); exp_consume(A, 2, scr, F.lane);
        if (has) exp_issue(nxt, 0, A);
        exp_consume(B, 3, scr, F.lane);
        exp_flush(cur, scr, F.lane);
        if (!has) break;
        cur = nxt; it = itn;
    }
}
__device__ __forceinline__ void p1_deferred_items(Frame& F) {
    if (F.G != 256 || F.bx < P1_IDLE0) { if (F.G != 256) { LAS unsigned* scr = (LAS unsigned*)(F.lds + F.wave * 16896); p0_expert_run(F, P0_IEXP - P0_DEFER, F.vcu * NWAVES + F.wave, F.G * NWAVES, P0_DEFER, scr); } return; }
    LAS unsigned* scr = (LAS unsigned*)(F.lds + F.wave * 16896);
    p0_expert_run(F, P0_IEXP - P0_DEFER, (F.bx - P1_IDLE0) * NWAVES + F.wave, (256 - P1_IDLE0) * NWAVES, P0_DEFER, scr);
}
__device__ __forceinline__ void p0_prologue(Frame& F) {
    LAS unsigned* scr = (LAS unsigned*)(F.lds + F.wave * 16896);
    const int gw = F.vcu * NWAVES + F.wave, NGW = F.G * NWAVES;
    const float* w_in = F.in[3]; const float* w_kv = F.in[14]; const float* w_out = F.in[15];
    f16* WinT = (f16*)(F.ws + WS_WINT); f16* WoutT = (f16*)(F.ws + WS_WOUTT); f16* WkvT = (f16*)(F.ws + WS_WKVT);
    constexpr int I_IN = 8 * (DIN / 64), I_OUT = 8 * (D / 64), I_KV = 8 * (2 * DX / 64);
    constexpr int NITEMS = I_IN + I_OUT + I_KV + (P0_IEXP - P0_DEFER);
    p0_expert_run(F, 0, gw, NGW, P0_IEXP - P0_DEFER, scr);
    for (int it = (P0_IEXP - P0_DEFER) / NGW * NGW + gw; it < NITEMS; it += NGW) {
        int r = it;
        if (r < P0_IEXP - P0_DEFER) continue;
        r -= (P0_IEXP - P0_DEFER);
        if (r < I_IN) { const int nb = r >> 3, kb = r & 7; p0_transpose_item(w_in, DIN, kb * 128, nb * 64, WinT, nb * 64, scr, F.lane); continue; } r -= I_IN;
        if (r < I_OUT) { const int nb = r >> 3, kb = r & 7; p0_transpose_item(w_out, D, kb * 128, nb * 64, WoutT, nb * 64, scr, F.lane); continue; } r -= I_OUT;
        { const int nb = r >> 3, kb = r & 7; p0_transpose_item(w_kv, 2 * DX, kb * 128, nb * 64, WkvT, nb * 64, scr, F.lane); }
    }
    f16* H0 = (f16*)(F.ws + WS_H0); f16* MEMN = (f16*)(F.ws + WS_MEMN);
    for (int m = gw; m < T + BATCH * NMEM; m += NGW) {
        if (m < T) rms_row_f16(F.in[0] + (size_t)m * D, F.in[2], H0 + (size_t)m * D, F.lane);
        else rms_row_f16(F.in[1] + (size_t)(m - T) * D, F.in[13], MEMN + (size_t)(m - T) * D, F.lane);
    }
    { unsigned long long* agz = (unsigned long long*)(F.ws + WS_AGG) + (size_t)F.bx * DRNN; if (F.bx < T / 64) agz[F.tid] = 0ull; if (F.bx < 16) agz[(size_t)256 * DRNN + F.tid] = 0ull; }
    if (gw == 0) { u32x4* z = (u32x4*)(F.ws + WS_X1N + (size_t)T * D); z[F.lane] = (u32x4){0u, 0u, 0u, 0u}; if (F.lane == 0) ((float*)(F.ws + WS_TOPG))[TK] = 0.f; }
}

struct SchedP1 {
    static constexpr bool GATHER = false, PREFETCH = false, HALVES = false;
    const char* H0; const char* WinT; const char* MEMN; const char* WkvT; int G, c;
    __device__ __forceinline__ bool next(int i, pg::Unit& u) const {
        constexpr int NP = 64 * 6;
        int L;
        if (G == 256) {
            if (c < P1_NGEMM) { L = i * P1_NGEMM + c; if (L >= NP) return false; }
            else { if (i > 0 || c >= P1_NGEMM + 4) return false; L = NP + (c - P1_NGEMM); }
        } else { L = i * G + c; if (L >= NP + 4) return false; }
        if (L < NP) {
            int wgid = L; { const int q = NP / 8, xcd = wgid % 8, off = wgid / 8; wgid = xcd * q + off; }
            const int nig = 8 * 6, gid = wgid / nig, fm = gid * 8;
            u.pm = fm + ((wgid % nig) % 8); u.pn = (wgid % nig) / 8; u.kind = 0;
            u.A = H0 + (size_t)u.pm * 256 * pg::ROWB; u.B = WinT + (size_t)u.pn * 256 * pg::ROWB;
                    u.e = 0; u.hrow = u.pm * 256; u.p0 = u.pn * 256; u.cnt = DIN;
        } else {
            const int q = L - NP, b = q >> 1, v = q & 1; u.pm = b; u.pn = v; u.kind = 1; u.e = 1 + q; u.hrow = 0; u.p0 = 0; u.cnt = DX;
            const char* mb = MEMN + (size_t)b * 256 * pg::ROWB; const char* wv = WkvT + (size_t)v * 256 * pg::ROWB;
            u.A = v ? wv : mb; u.B = v ? mb : wv; }
        return true;
    }
    __device__ __forceinline__ void rows(const pg::Unit&, int R0, unsigned colb, unsigned (&ar)[4]) const { pg::dense_rows(R0, colb, ar); }
};
struct EpiP1 {
    static constexpr bool PERM = true, FP8 = false;
    f16* proj; f16* Kh; f16* VT;
    __device__ __forceinline__ void init(f32x4 (&acc)[2][2][4][2], const pg::Unit&, int, int, int, int) const { pg::zero_acc(acc); }
    __device__ __forceinline__ void prefetch(const pg::Unit&, int, int, unsigned) const {}
    __device__ __forceinline__ void operator()(const f32x4 (&acc)[2][2][4][2], const pg::Unit& u, int wr, int wc, int fr, int fq, const LAS unsigned char*) const {
        f16* base = proj;
        if (u.e != 0) { const int q = u.e - 1; base = ((q & 1) ? VT : Kh) + (size_t)(q >> 1) * NMEM * DX; }
        const int ld = u.cnt;
        const int row0 = u.hrow + wr * 64 + fr, col0 = u.p0 + wc * 32 + 8 * fq;
#pragma unroll
        for (int ai = 0; ai < 2; ++ai)
#pragma unroll
            for (int m = 0; m < 4; ++m) { f16* rowp = base + (size_t)(row0 + ai * 128 + m * 16) * ld + col0;
#pragma unroll
                for (int bj = 0; bj < 2; ++bj) { const f32x4 v0 = acc[ai][bj][m][0], v1 = acc[ai][bj][m][1];
                    u32x4 w; w.x = pk_f16(v0[0], v0[1]); w.y = pk_f16(v0[2], v0[3]); w.z = pk_f16(v1[0], v1[1]); w.w = pk_f16(v1[2], v1[3]);
                    *(u32x4*)(rowp + bj * 128) = w; } }
    }
};

struct SchedP3 {
    static constexpr bool GATHER = false, PREFETCH = false, HALVES = false;
    const char* MIX; const char* WoutT; int L;
    __device__ __forceinline__ bool next(int i, pg::Unit& u) const {
        constexpr int NP = 64 * 4;
        if (i > 0 || L >= NP) return false;
        int wgid = L; { const int q = NP / 8, xcd = wgid % 8, off = wgid / 8; wgid = xcd * q + off; }
        const int nig = 8 * 4, gid = wgid / nig, fm = gid * 8;
        u.pm = fm + ((wgid % nig) % 8); u.pn = (wgid % nig) / 8; u.kind = 0;
        u.A = MIX + (size_t)u.pm * 256 * pg::ROWB; u.B = WoutT + (size_t)u.pn * 256 * pg::ROWB;
        u.e = 0; u.p0 = 0; u.cnt = 0; u.hrow = 0;
        return true;
    }
    __device__ __forceinline__ void rows(const pg::Unit&, int R0, unsigned colb, unsigned (&ar)[4]) const { pg::dense_rows(R0, colb, ar); }
};
struct EpiP3 {
    static constexpr bool PERM = true, FP8 = false;
    const float* x; f16* x1; unsigned char* x1g8; const float* gffn; const f16* WrH; float* PARTL; float* SSQP; LAS unsigned char* lds;
    __device__ __forceinline__ void init(f32x4 (&acc)[2][2][4][2], const pg::Unit& u, int wr, int wc, int fr, int fq) const {
        const float* xp = x + (size_t)(u.pm * 256 + wr * 64 + fr) * D + u.pn * 256 + wc * 32 + 8 * fq;
#pragma unroll
        for (int ai = 0; ai < 2; ++ai)
#pragma unroll
            for (int m = 0; m < 4; ++m)
#pragma unroll
                for (int bj = 0; bj < 2; ++bj)
#pragma unroll
                    for (int n = 0; n < 2; ++n) acc[ai][bj][m][n] = __builtin_nontemporal_load((const f32x4*)(xp + (size_t)(ai * 128 + m * 16) * D + bj * 128 + 4 * n));
    }
    __device__ __forceinline__ void prefetch(const pg::Unit&, int, int, unsigned) const {}
    __device__ __forceinline__ void operator()(const f32x4 (&acc)[2][2][4][2], const pg::Unit& u, int wr, int wc, int fr, int fq, const LAS unsigned char*) const {
        const int wave = wr * 4 + wc;
        const int row0 = u.pm * 256 + wr * 64 + fr, col0 = u.pn * 256 + wc * 32 + 8 * fq;
        f16x8 wrh[2][2], wrl[2][2];
        f32x4 gg[2][2];
#pragma unroll
        for (int bj = 0; bj < 2; ++bj) {
#pragma unroll
            for (int eh = 0; eh < 2; ++eh) { const size_t o = (size_t)(16 * eh + fr) * D + col0 + 128 * bj; wrh[bj][eh] = *(const f16x8*)(WrH + o); wrl[bj][eh] = *(const f16x8*)(WrH + (size_t)NE * D + o); }
            gg[bj][0] = *(const f32x4*)(gffn + col0 + 128 * bj) * SC_X; gg[bj][1] = *(const f32x4*)(gffn + col0 + 128 * bj + 4) * SC_X;
        }
        asm volatile("s_waitcnt vmcnt(0)" ::: "memory");
        __builtin_amdgcn_s_barrier();
        LAS float* PL = (LAS float*)lds + wave * (128 * 32);
        LAS float* SS = (LAS float*)(lds + LDS_EPI_OFF) + wave * 128;
#pragma unroll
        for (int ai = 0; ai < 2; ++ai)
#pragma unroll
            for (int p = 0; p < 2; ++p) {
                u32x2 wv[2][2];
#pragma unroll
                for (int mm = 0; mm < 2; ++mm) {
                    const int m = 2 * p + mm;
                    const size_t off = (size_t)(row0 + ai * 128 + m * 16) * D + col0;
                    f32x4 L0 = {0.f, 0.f, 0.f, 0.f}, L1 = {0.f, 0.f, 0.f, 0.f}; float ss = 0.f;
#pragma unroll
                    for (int bj = 0; bj < 2; ++bj) {
                        const f32x4 v0 = acc[ai][bj][m][0], v1 = acc[ai][bj][m][1];
                        u32x4 w; w.x = pk_f16(v0[0], v0[1]); w.y = pk_f16(v0[2], v0[3]); w.z = pk_f16(v1[0], v1[1]); w.w = pk_f16(v1[2], v1[3]);
                        *(u32x4*)(x1 + off + bj * 128) = w;
                        const f16x8 hv = __builtin_bit_cast(f16x8, w);
                        const f32x4 h0 = {(float)hv[0], (float)hv[1], (float)hv[2], (float)hv[3]}, h1 = {(float)hv[4], (float)hv[5], (float)hv[6], (float)hv[7]};
                        ss += ((h0[0] * h0[0] + h0[1] * h0[1]) + (h0[2] * h0[2] + h0[3] * h0[3])) + ((h1[0] * h1[0] + h1[1] * h1[1]) + (h1[2] * h1[2] + h1[3] * h1[3]));
                        const f32x4 q0 = h0 * gg[bj][0], q1 = h1 * gg[bj][1];
                        wv[mm][bj].x = pk4_fp8(q0[0], q0[1], q0[2], q0[3]); wv[mm][bj].y = pk4_fp8(q1[0], q1[1], q1[2], q1[3]);
                        L0 = __builtin_amdgcn_mfma_f32_16x16x32_f16(wrh[bj][0], hv, L0, 0, 0, 0); L1 = __builtin_amdgcn_mfma_f32_16x16x32_f16(wrh[bj][1], hv, L1, 0, 0, 0);
                        L0 = __builtin_amdgcn_mfma_f32_16x16x32_f16(wrl[bj][0], hv, L0, 0, 0, 0); L1 = __builtin_amdgcn_mfma_f32_16x16x32_f16(wrl[bj][1], hv, L1, 0, 0, 0);
                    }
                    const int rl = (ai * 4 + m) * 16 + fr;
                    *(LAS f32x4*)(PL + rl * 32 + 4 * fq) = L0; *(LAS f32x4*)(PL + rl * 32 + 16 + 4 * fq) = L1;
                    ss += __shfl_xor(ss, 16); ss += __shfl_xor(ss, 32);
                    if (fq == 0) SS[rl] = ss;
                }
#pragma unroll
                for (int bj = 0; bj < 2; ++bj) {
                    const auto rx = __builtin_amdgcn_permlane16_swap(wv[0][bj].x, wv[1][bj].x, false, false);
                    const auto ry = __builtin_amdgcn_permlane16_swap(wv[0][bj].y, wv[1][bj].y, false, false);
                    const int r = row0 + ai * 128 + (2 * p + (fq & 1)) * 16;
                    u32x4 w16; w16.x = rx[0]; w16.y = ry[0]; w16.z = rx[1]; w16.w = ry[1];
                    *(u32x4*)(x1g8 + (size_t)r * D + u.pn * 256 + wc * 32 + 16 * (fq >> 1) + bj * 128) = w16;
                }
            }
        asm volatile("s_waitcnt lgkmcnt(0)" ::: "memory");
        __builtin_amdgcn_s_barrier();
        {
            const int t = (int)threadIdx.x, r256 = t >> 1, eh = t & 1;
            const int ai_ = r256 >> 7, wr_ = (r256 >> 6) & 1, rl = (ai_ * 4 + ((r256 >> 4) & 3)) * 16 + (r256 & 15);
            const LAS float* pl = (const LAS float*)lds + (wr_ * 4) * (128 * 32) + rl * 32 + 16 * eh;
            const size_t grow = (size_t)u.pn * T + (size_t)u.pm * 256 + r256;
#pragma unroll
            for (int q = 0; q < 4; ++q) {
                f32x4 sum = *(const LAS f32x4*)(pl + 4 * q);
#pragma unroll
                for (int c = 1; c < 4; ++c) sum += *(const LAS f32x4*)(pl + c * (128 * 32) + 4 * q);
                *(f32x4*)(PARTL + grow * 32 + 16 * eh + 4 * q) = sum;
            }
            if (eh == 0) { const LAS float* sp = (const LAS float*)(lds + LDS_EPI_OFF) + (wr_ * 4) * 128 + rl; SSQP[grow] = ((sp[0] + sp[128]) + sp[256]) + sp[384]; }
        }
    }
};

template <int NCT, bool GATHER_> struct SchedMoe {
    static constexpr bool GATHER = GATHER_, PREFETCH = true, HALVES = true;
    const char* Abase; const char* Wbase; size_t wstride_e; const int* list; const LAS int* tab; int G, c;
    __device__ __forceinline__ bool next(int i, pg::Unit& u) const {
        const int ntiles = __builtin_amdgcn_readfirstlane(tab[NE]);
        const int per = G >> 3;
        const int U = ntiles * NCT, Uc = (U + 7) / 8, x = c & 7, j = c >> 3;
        int Ux = U - x * Uc; Ux = Ux < 0 ? 0 : (Ux > Uc ? Uc : Ux);
        const int nfull = Ux / per, rem = Ux - nfull * per;
        int Lx, half = 0;
        if (i < nfull) Lx = j + per * i;
        else if (i == nfull && rem > 0) {
            if (2 * rem <= per) { if (j >= 2 * rem) return false; Lx = nfull * per + (j >> 1); half = 1 + (j & 1); }
            else { if (j >= rem) return false; Lx = nfull * per + j; }
        } else return false;
        const int L = x * Uc + Lx;
        const int RT = L / NCT, ct = L % NCT;
        const int ln = (int)(threadIdx.x & 63u);
        const unsigned long long mm = __ballot((ln < NE) && (tab[ln & 31] <= RT));
        const int e = 63 - __builtin_clzll(mm);
        const int t0 = __builtin_amdgcn_readfirstlane(tab[e]);
        u.e = e; u.p0 = (RT - t0) * 256; u.cnt = __builtin_amdgcn_readfirstlane(tab[40 + e]); u.hrow = RT * 256; u.pn = ct; u.pm = RT;
        if (half == 0 && u.cnt - u.p0 <= 128) half = 1;
        u.kind = half;
        u.B = Wbase + (size_t)e * wstride_e + (size_t)ct * 256 * pg::ROWB8;
        u.A = GATHER_ ? Abase : Abase + (size_t)u.hrow * pg::ROWB8;
        return true;
    }
    __device__ __forceinline__ void rows_issue(const pg::Unit& u, int R0, unsigned (&raw)[4]) const {
        const int idx = __builtin_amdgcn_readfirstlane(u.e * T + u.p0);
        const char* lb = (const char*)(list + idx);
        const unsigned off = (unsigned)R0 * 4u;
        asm volatile("global_load_dword %0, %4, %5\n\tglobal_load_dword %1, %4, %5 offset:256\n\tglobal_load_dword %2, %4, %5 offset:512\n\tglobal_load_dword %3, %4, %5 offset:768"
                     : "=&v"(raw[0]), "=&v"(raw[1]), "=&v"(raw[2]), "=&v"(raw[3]) : "v"(off), "s"(lb) : "memory");
    }
    __device__ __forceinline__ void rows_finish(const pg::Unit& u, int R0, unsigned colb, const unsigned (&raw)[4], unsigned (&ar)[4]) const {
#pragma unroll
        for (int q = 0; q < 4; ++q) { const int pos = u.p0 + R0 + 64 * q; const unsigned tok = (pos < u.cnt) ? (raw[q] >> 2) : (unsigned)T; ar[q] = tok * pg::ROWB8 + colb; }
    }
    __device__ __forceinline__ void rows(const pg::Unit& u, int R0, unsigned colb, unsigned (&ar)[4]) const {
        if (GATHER_) {
#pragma unroll
            for (int q = 0; q < 4; ++q) { const int pos = u.p0 + R0 + 64 * q; const int posc = pos < u.cnt ? pos : u.cnt - 1; const int le = list[u.e * T + posc]; const int tok = pos < u.cnt ? (le >> 2) : T; ar[q] = (unsigned)tok * pg::ROWB8 + colb; }
        } else pg::dense_rows<pg::ROWB8>(R0, colb, ar);
    }
};
struct EpiGU {
    static constexpr bool PERM = true, FP8 = true;
    const float* b_gu; const float* rlist; unsigned char* Hbuf; int skip;
    __device__ __forceinline__ void init(f32x4 (&acc)[2][2][4][2], const pg::Unit&, int, int, int, int) const { pg::zero_acc(acc); }
    __device__ __forceinline__ void prefetch(const pg::Unit& u, int wid, int lane, unsigned slot) const {
        if (wid == 0) { const unsigned voff = (unsigned)((lane < 32 ? (u.pn * 128 + 4 * lane) : (DFF + u.pn * 128 + 4 * (lane - 32))) * 4); pg::glds16n(pg::uptr((const char*)(b_gu + (size_t)u.e * 2 * DFF)), voff, slot);
            pg::glds16n(pg::uptr((const char*)(rlist + (size_t)u.e * T + u.p0)), (unsigned)lane * 16u, slot + 1024u); }
    }
    __device__ __forceinline__ void operator()(const f32x4 (&acc)[2][2][4][2], const pg::Unit& u, int wr, int wc, int fr, int fq, const LAS unsigned char* slot) const {
        if (skip) return;
        const int cj = u.pn * 128 + wc * 32 + 8 * fq;
        f32x4 bgv[2], buv[2];
#pragma unroll
        for (int n = 0; n < 2; ++n) { bgv[n] = *(const LAS f32x4*)(slot + (wc * 32 + 8 * fq + 4 * n) * 4); buv[n] = *(const LAS f32x4*)(slot + 512 + (wc * 32 + 8 * fq + 4 * n) * 4); }
        const int cj16 = u.pn * 128 + wc * 32 + 16 * (fq >> 1);
#pragma unroll
        for (int ai = 0; ai < 2; ++ai) {
            if (u.kind == 2 - ai) continue;
            u32x2 wv[4];
#pragma unroll
            for (int m = 0; m < 4; ++m) {
                float o[8];
                const int rl = ai * 128 + wr * 64 + m * 16 + fr;
                const float rsc = ((u.p0 + rl) < u.cnt ? ((const LAS float*)(slot + 1024))[rl] : 0.f) * (1.f / (SC_W * SC_X));
#pragma unroll
                for (int n = 0; n < 2; ++n)
#pragma unroll
                    for (int j = 0; j < 4; j += 2) {
                        constexpr float c1 = -1.702f * 1.4426950408889634f, kk = SC_H / c1;
                        const f32x2 ag = {acc[ai][0][m][n][j], acc[ai][0][m][n][j + 1]}, au_ = {acc[ai][1][m][n][j], acc[ai][1][m][n][j + 1]};
                        const f32x2 bg2 = {bgv[n][j], bgv[n][j + 1]}, bu2 = {buv[n][j], buv[n][j + 1]};
                        f32x2 t = ag * (rsc * c1) + bg2 * c1, uv = au_ * rsc + bu2;
                        t[0] = fmaxf(t[0], 7.f * c1); t[1] = fmaxf(t[1], 7.f * c1);
                        uv[0] = __builtin_amdgcn_fmed3f(uv[0], -7.f, 7.f); uv[1] = __builtin_amdgcn_fmed3f(uv[1], -7.f, 7.f);
                        f32x2 e2 = {__builtin_amdgcn_exp2f(t[0]), __builtin_amdgcn_exp2f(t[1])};
                        e2 = e2 + 1.f;
                        const f32x2 sg = {__builtin_amdgcn_rcpf(e2[0]), __builtin_amdgcn_rcpf(e2[1])};
                        const f32x2 ov = (uv * kk + kk) * (t * sg);
                        o[4 * n + j] = ov[0]; o[4 * n + j + 1] = ov[1];
                    }
                wv[m].x = pk4_fp8(o[0], o[1], o[2], o[3]); wv[m].y = pk4_fp8(o[4], o[5], o[6], o[7]);
            }
#pragma unroll
            for (int p = 0; p < 2; ++p) {
                const auto rx = __builtin_amdgcn_permlane16_swap(wv[2 * p].x, wv[2 * p + 1].x, false, false);
                const auto ry = __builtin_amdgcn_permlane16_swap(wv[2 * p].y, wv[2 * p + 1].y, false, false);
                const int r = ai * 128 + wr * 64 + (2 * p + (fq & 1)) * 16 + fr;
                u32x4 w16; w16.x = rx[0]; w16.y = ry[0]; w16.z = rx[1]; w16.w = ry[1];
                *(u32x4*)(Hbuf + (size_t)(u.hrow + r) * DFF + cj16) = w16;
            }
        }
    }
};
struct EpiDown {
    static constexpr bool PERM = true, FP8 = true;
    const float* b_down; const int* list; const float* glist; unsigned char* Y; int skip;
    __device__ __forceinline__ void init(f32x4 (&acc)[2][2][4][2], const pg::Unit&, int, int, int, int) const { pg::zero_acc(acc); }
    __device__ __forceinline__ void prefetch(const pg::Unit& u, int wid, int lane, unsigned slot) const {
        if (wid == 0) { const unsigned voff = (unsigned)lane * 16u;
            pg::glds16n(pg::uptr((const char*)(b_down + (size_t)u.e * D + u.pn * 256)), voff, slot);
            pg::glds16n(pg::uptr((const char*)(list + (size_t)u.e * T + u.p0)), voff, slot + 1024u);
            pg::glds16n(pg::uptr((const char*)(glist + (size_t)u.e * T + u.p0)), voff, slot + 2048u); }
    }
    __device__ __forceinline__ void operator()(const f32x4 (&acc)[2][2][4][2], const pg::Unit& u, int wr, int wc, int fr, int fq, const LAS unsigned char* slotp) const {
        if (skip) return;
        const int c0 = u.pn * 256 + wc * 32 + 8 * fq;
        f32x4 bv[2][2];
#pragma unroll
        for (int bj = 0; bj < 2; ++bj)
#pragma unroll
            for (int n = 0; n < 2; ++n) bv[bj][n] = *(const LAS f32x4*)(slotp + (bj * 128 + wc * 32 + 8 * fq + 4 * n) * 4);
        const int c16 = u.pn * 256 + wc * 32 + 16 * (fq >> 1);
#pragma unroll
        for (int ai = 0; ai < 2; ++ai) {
            if (u.kind == 2 - ai) continue;
#pragma unroll
            for (int p = 0; p < 2; ++p) {
                const int rA = ai * 128 + wr * 64 + (2 * p) * 16 + fr, rB = rA + 16;
                const int slA = ((const LAS int*)(slotp + 1024))[rA], slB = ((const LAS int*)(slotp + 1024))[rB];
                const float glA = ((const LAS float*)(slotp + 2048))[rA], glB = ((const LAS float*)(slotp + 2048))[rB];
                const bool okA = (u.p0 + rA) < u.cnt, okB = (u.p0 + rB) < u.cnt;
                const int slotA = okA ? slA : TK, slotB = okB ? slB : TK;
                const float gtA = (okA ? glA : 0.f) * SC_Y, gtB = (okB ? glB : 0.f) * SC_Y;
                const int slot = (fq & 1) ? slotB : slotA;
                unsigned char* rowp = Y + (size_t)slot * D + c16;
#pragma unroll
                for (int bj = 0; bj < 2; ++bj) {
                    const f32x4 a0 = (acc[ai][bj][2 * p][0] * (1.f / (SC_W * SC_H)) + bv[bj][0]) * gtA, a1 = (acc[ai][bj][2 * p][1] * (1.f / (SC_W * SC_H)) + bv[bj][1]) * gtA;
                    const f32x4 b0 = (acc[ai][bj][2 * p + 1][0] * (1.f / (SC_W * SC_H)) + bv[bj][0]) * gtB, b1 = (acc[ai][bj][2 * p + 1][1] * (1.f / (SC_W * SC_H)) + bv[bj][1]) * gtB;
                    const unsigned ax = pk4_fp8(a0[0], a0[1], a0[2], a0[3]), ay = pk4_fp8(a1[0], a1[1], a1[2], a1[3]);
                    const unsigned bx = pk4_fp8(b0[0], b0[1], b0[2], b0[3]), by = pk4_fp8(b1[0], b1[1], b1[2], b1[3]);
                    const auto rx = __builtin_amdgcn_permlane16_swap(ax, bx, false, false);
                    const auto ry = __builtin_amdgcn_permlane16_swap(ay, by, false, false);
                    u32x4 w16; w16.x = rx[0]; w16.y = ry[0]; w16.z = rx[1]; w16.w = ry[1];
                    *(u32x4*)(rowp + bj * 128) = w16;
                }
            }
        }
    }
};
__device__ __forceinline__ void moe_table(Frame& F) {
    LAS int* tab = (LAS int*)(F.lds + LDS_CTL_OFF + 256);
    if (F.tid == 0) { int tt = 0; for (int e = 0; e < NE; ++e) { const int c = (int)F.ctl[CW_COUNTS + 64 * e]; tab[e] = tt; tab[40 + e] = c; tt += (c + 255) >> 8; } tab[NE] = tt; }
    __syncthreads();
}

constexpr size_t SW_WAT = 0, SW_WIT = 64 * 1024, SW_WPT = 128 * 1024, SW_WRP = 256 * 1024;
__device__ __forceinline__ void p0_small(Frame& F) {
    const int gt = F.vcu * (NWAVES * 64) + F.tid, NTH = F.G * NWAVES * 64;
    f16* WaT = (f16*)(F.ws + WS_SMALLW + SW_WAT); f16* WiT = (f16*)(F.ws + WS_SMALLW + SW_WIT); f16* WpT = (f16*)(F.ws + WS_SMALLW + SW_WPT); f16* WrH = (f16*)(F.ws + WS_SMALLW + SW_WRP); f16* WrL = WrH + NE * D;
    const float* w_a = F.in[6]; const float* w_i = F.in[8]; const float* w_p = F.in[11]; const float* gffn = F.in[16]; const float* w_r = F.in[17];
    for (int idx = gt; idx < NH * 64 * 64; idx += NTH) { const int h = idx >> 12, j = (idx >> 6) & 63, i = idx & 63; WaT[idx] = (f16)w_a[(h * 64 + i) * 64 + j]; WiT[idx] = (f16)w_i[(h * 64 + i) * 64 + j]; }
    for (int idx = gt; idx < 4 * 64 * 64; idx += NTH) { const int g = idx >> 12, j = (idx >> 6) & 63, i = idx & 63; WpT[idx] = (f16)w_p[(g * 64 + i) * 64 + j]; }
    for (int idx = gt; idx < D * NE; idx += NTH) { const int k = idx >> 5, e = idx & 31; const float wv = 1024.f * (gffn[k] * w_r[idx]); const f16 hh = (f16)wv; WrH[e * D + k] = hh; WrL[e * D + k] = (f16)(wv - (float)hh); }
}

typedef float f32x16 __attribute__((ext_vector_type(16)));
constexpr int UCS_PITCH = 520;
constexpr int DT_PITCH = 264;
constexpr int P2_DT_OFF = 64 * UCS_PITCH * 2;
constexpr int P2_STG_OFF = P2_DT_OFF + 64 * DT_PITCH * 2;
constexpr float LOG2E = 1.4426950408889634f;
__device__ __forceinline__ float sigmoid_fast(float x) { return __builtin_amdgcn_rcpf(1.f + __builtin_amdgcn_exp2f(-x * LOG2E)); }
__device__ __forceinline__ float gelu_tanh_fast(float x) {
    const float u2 = 1.5957691216057308f * (x + 0.044715f * x * x * x);
    return x * sigmoid_fast(u2);
}
template <int W> __device__ __forceinline__ void pool_d2(const unsigned* up2, int tpos0, LAS unsigned* dst) {
    f32x2 u[16 + W - 1];
#pragma unroll
    for (int i = 0; i < 16 + W - 1; ++i) {
        const int rel = i - (W - 1), lim = -tpos0, rc = rel < lim ? lim : rel;
        const unsigned ld = up2[(ptrdiff_t)rc * (DIN / 2)];
        const unsigned raw = (rel >= lim) ? ld : 0u;
        const f16x2 h = __builtin_bit_cast(f16x2, raw);
        u[i] = (f32x2){(float)h[0], (float)h[1]};
    }
#pragma unroll
    for (int t = 0; t < 16; ++t) {
        f32x2 sacc = {0.f, 0.f};
#pragma unroll
        for (int q = 0; q < W; ++q) sacc += u[t + (W - 1) - q];
        const int n = (tpos0 + t + 1 < W) ? (tpos0 + t + 1) : W;
        const float rn = 1.f / (float)n;
        const f32x2 d = sacc * rn - u[t + W - 1];
        dst[t * (DT_PITCH / 2)] = pk_f16(d[0], d[1]);
    }
}
__device__ __forceinline__ void lookback16(const unsigned long long* base, int n, float& la, float& lh) {
    unsigned long long g[16];
    for (unsigned spin = 0;; ++spin) {
        bool ok = true;
#pragma unroll
        for (int i = 0; i < 16; ++i) { const int k = i < n ? i : (n > 0 ? n - 1 : 0);
            g[i] = __hip_atomic_load((unsigned long long*)base + (size_t)k * DRNN, __ATOMIC_RELAXED, __HIP_MEMORY_SCOPE_AGENT);
            if (i < n) ok = ok && ((unsigned)g[i] != 0u); }
        if (ok || spin > (1u << 18)) break;
        __builtin_amdgcn_s_sleep(2);
    }
    la = 1.f; lh = 0.f;
#pragma unroll
    for (int i = 0; i < 16; ++i) if (i < n) { const float a = __uint_as_float((unsigned)g[i]), hh = __uint_as_float((unsigned)(g[i] >> 32)); lh = a * lh + hh; la = a * la; }
}
__device__ __forceinline__ void p2_mixer(Frame& F) {
    const f16* proj = (const f16*)(F.ws + WS_PROJ);
    f16* mixed = (f16*)(F.ws + WS_MIXED);
    unsigned long long* AGG = (unsigned long long*)(F.ws + WS_AGG);
    const f16* WaT = (const f16*)(F.ws + WS_SMALLW + SW_WAT); const f16* WiT = (const f16*)(F.ws + WS_SMALLW + SW_WIT); const f16* WpT = (const f16*)(F.ws + WS_SMALLW + SW_WPT);
    const f16* Kh = (const f16*)(F.ws + WS_KH); const f16* VT = (const f16*)(F.ws + WS_VT);
    const float* conv_w = F.in[4]; const float* conv_b = F.in[5]; const float* b_a = F.in[7]; const float* b_i = F.in[9]; const float* lam = F.in[10]; const float* pool_scale = F.in[12];
    LAS f16* ucs = (LAS f16*)(F.lds); LAS f16* dts = (LAS f16*)(F.lds + P2_DT_OFF);
    const int w = F.wave;
    const int sub = F.flags ? F.flags : 31;
    for (int ch = F.bx; ch < T / 64; ch += F.G) {
        int tid = F.tid; asm volatile("" : "+v"(tid));
        const int lane = tid & 63, hi = lane >> 5, l31 = lane & 31;
        const int tok0 = ch * 64, t0 = tok0 % SEQ, b = tok0 / SEQ;
        if (sub & 1) {
            const int cp = tid & 255, th = tid >> 8, c0 = 2 * cp;
            const f32x2 cw0 = *(const f32x2*)(conv_w + c0), cw1 = *(const f32x2*)(conv_w + DRNN + c0), cw2 = *(const f32x2*)(conv_w + 2 * DRNN + c0), cw3 = *(const f32x2*)(conv_w + 3 * DRNN + c0), cbv = *(const f32x2*)(conv_b + c0);
            const unsigned* up2 = (const unsigned*)(proj + (size_t)(tok0 + 32 * th) * DIN + c0);
            unsigned raw[35];
#pragma unroll
            for (int i = 0; i < 35; ++i) {
                const int rel = i - 3, lim = -(t0 + 32 * th), rc = rel < lim ? lim : rel;
                const unsigned v = up2[(ptrdiff_t)rc * (DIN / 2)];
                raw[i] = (rel >= lim) ? v : 0u;
            }
            LAS unsigned* dstc = (LAS unsigned*)(ucs + (32 * th) * UCS_PITCH + c0);
            f32x2 u0, u1, u2;
            { const f16x2 h0 = __builtin_bit_cast(f16x2, raw[0]), h1 = __builtin_bit_cast(f16x2, raw[1]), h2 = __builtin_bit_cast(f16x2, raw[2]);
              u0 = (f32x2){(float)h0[0], (float)h0[1]}; u1 = (f32x2){(float)h1[0], (float)h1[1]}; u2 = (f32x2){(float)h2[0], (float)h2[1]}; }
#pragma unroll
            for (int t = 0; t < 32; ++t) {
                const f16x2 h3 = __builtin_bit_cast(f16x2, raw[t + 3]);
                const f32x2 u3 = (f32x2){(float)h3[0], (float)h3[1]};
                const f32x2 v = cbv + cw0 * u0 + cw1 * u1 + cw2 * u2 + cw3 * u3;
                dstc[t * (UCS_PITCH / 2)] = pk_f16(v[0], v[1]);
                u0 = u1; u1 = u2; u2 = u3;
            }
        }
        if (sub & 2) {
            const int g = w & 3, half = w >> 2, cpl = lane & 31, q2 = lane >> 5, ts = 32 * half + 16 * q2, c0 = 64 * g + 2 * cpl;
            const unsigned* pp2 = (const unsigned*)(proj + (size_t)(tok0 + ts) * DIN + 2 * DRNN + c0);
            LAS unsigned* dst = (LAS unsigned*)(dts + ts * DT_PITCH + c0);
            if (g == 0) pool_d2<2>(pp2, t0 + ts, dst); else if (g == 1) pool_d2<4>(pp2, t0 + ts, dst); else if (g == 2) pool_d2<8>(pp2, t0 + ts, dst); else pool_d2<16>(pp2, t0 + ts, dst);
        }
        __syncthreads();
        unsigned sth_[4][8], stp_[4][8];
#pragma unroll
        for (int a = 0; a < 4; ++a)
#pragma unroll
            for (int q = 0; q < 8; ++q) { sth_[a][q] = 0u; stp_[a][q] = 0u; }
        float ownA = 1.f, ownH = 0.f;
        if (sub & 4) {
            const int h = w;
#pragma unroll 1
            for (int cb = 0; cb < 2; ++cb) {
                const int cch = 64 * h + 32 * cb + l31;
                const float ba = b_a[cch], bi = b_i[cch];
                const float sp8 = -8.f * log1pf(expf(-lam[cch]));
                f16x8 wa[4], wi[4], idv[2];
#pragma unroll
                for (int s = 0; s < 4; ++s) {
                    wa[s] = *(const f16x8*)(WaT + ((size_t)(h * 64 + 32 * cb + l31) * 64 + 16 * s + 8 * hi));
                    wi[s] = *(const f16x8*)(WiT + ((size_t)(h * 64 + 32 * cb + l31) * 64 + 16 * s + 8 * hi));
                }
#pragma unroll
                for (int ss = 0; ss < 2; ++ss) {
                    const int jj = l31 - 16 * ss - 8 * hi;
#pragma unroll
                    for (int j = 0; j < 8; ++j) idv[ss][j] = (j == jj) ? (f16)1.f : (f16)0.f;
                }
                float cc = 0.f, Q = 1.f;
#pragma unroll 1
                for (int tb = 0; tb < 2; ++tb) {
                    const LAS f16* arow_ = ucs + (32 * tb + l31) * UCS_PITCH + 64 * h + 8 * hi;
                    f32x16 ar, ai, au;
#pragma unroll
                    for (int r = 0; r < 16; ++r) { ar[r] = 0.f; ai[r] = 0.f; au[r] = 0.f; }
#pragma unroll
                    for (int s = 0; s < 4; ++s) {
                        const f16x8 af = *(const LAS f16x8*)(arow_ + 16 * s);
                        ar = __builtin_amdgcn_mfma_f32_32x32x16_f16(af, wa[s], ar, 0, 0, 0);
                        ai = __builtin_amdgcn_mfma_f32_32x32x16_f16(af, wi[s], ai, 0, 0, 0);
                        if ((s >> 1) == cb) au = __builtin_amdgcn_mfma_f32_32x32x16_f16(af, idv[s & 1], au, 0, 0, 0);
                    }
                    const int tbase = tok0 + 32 * tb + 4 * hi;
                    const f16* gp = proj + (size_t)tbase * DIN + DRNN + cch;
#pragma unroll
                    for (int r = 0; r < 16; ++r) {
                        const int dt = (r & 3) + 8 * (r >> 2);
                        const float rr = sigmoid_fast(ar[r] + ba), ii = sigmoid_fast(ai[r] + bi);
                        const float la = sp8 * rr;
                        const float a = __builtin_amdgcn_exp2f(la * LOG2E);
                        float mult = __builtin_amdgcn_sqrtf(fmaxf(__builtin_fmaf(-a, a, 1.f), 0.f));
                        if (t0 + 32 * tb + 4 * hi + dt == 0) mult = 1.f;
                        ar[r] = a; ai[r] = mult * (ii * au[r]);
                        au[r] = gelu_tanh_fast((float)gp[(size_t)dt * DIN]);
                    }
                    float cin[4], Qin[4];
#pragma unroll
                    for (int rg = 0; rg < 4; ++rg) {
                        float P = ar[4 * rg], hh = ai[4 * rg];
#pragma unroll
                        for (int q = 1; q < 4; ++q) { const float a = ar[4 * rg + q]; hh = a * hh + ai[4 * rg + q]; P = a * P; ar[4 * rg + q] = P; ai[4 * rg + q] = hh; }
                        const float oA = __shfl_xor(P, 32), oH = __shfl_xor(hh, 32);
                        const float A0 = hi ? oA : P, H0 = hi ? oH : hh;
                        const float A1 = hi ? P : oA, H1 = hi ? hh : oH;
                        const float c0 = cc, q0 = Q;
                        cc = A0 * cc + H0; Q = Q * A0;
                        const float c1 = cc, q1 = Q;
                        cc = A1 * cc + H1; Q = Q * A1;
                        cin[rg] = hi ? c1 : c0; Qin[rg] = hi ? q1 : q0;
                    }
#pragma unroll
                    for (int q = 0; q < 8; ++q) { sth_[3][q] = sth_[2][q]; sth_[2][q] = sth_[1][q]; sth_[1][q] = sth_[0][q]; stp_[3][q] = stp_[2][q]; stp_[2][q] = stp_[1][q]; stp_[1][q] = stp_[0][q]; }
#pragma unroll
                    for (int q = 0; q < 8; ++q) {
                        const int r0 = 2 * q, r1 = 2 * q + 1;
                        const float hl0 = ai[r0] + ar[r0] * cin[r0 >> 2], hl1 = ai[r1] + ar[r1] * cin[r1 >> 2];
                        const float pc0 = ar[r0] * Qin[r0 >> 2], pc1 = ar[r1] * Qin[r1 >> 2];
                        sth_[0][q] = pk_f16(hl0 * au[r0], hl1 * au[r1]); stp_[0][q] = pk_f16(pc0 * au[r0], pc1 * au[r1]);
                    }
                }
                if (hi == 0) __hip_atomic_store(AGG + ch * DRNN + cch, ((unsigned long long)__float_as_uint(cc) << 32) | (unsigned long long)__float_as_uint(Q), __ATOMIC_RELAXED, __HIP_MEMORY_SCOPE_AGENT);
                if (cb == hi) { ownA = Q; ownH = cc; }
            }
        }
        const int first = (ch / (SEQ / 64)) * (SEQ / 64), rel = ch - first, grp = rel >> 4, gi = rel & 15, gbase = first + 16 * grp;
        const unsigned long long* agc = AGG + lane + 64 * w;
        unsigned long long* AGG2 = AGG + 256 * DRNN;
        float la = 1.f, lh = 0.f;
        if ((sub & 4) && gi == 15) {
            lookback16(agc + (size_t)gbase * DRNN, 15, la, lh);
            const float ta = ownA * la, thh = ownA * lh + ownH;
            __hip_atomic_store(AGG2 + (size_t)((ch / (SEQ / 64)) * 8 + grp) * DRNN + lane + 64 * w, ((unsigned long long)__float_as_uint(thh) << 32) | __float_as_uint(ta), __ATOMIC_RELAXED, __HIP_MEMORY_SCOPE_AGENT);
        }
        if (sub & 8) {
            const int g = w & 3, th = w >> 2;
            f16x8 Bf[4];
#pragma unroll
            for (int s = 0; s < 4; ++s) Bf[s] = *(const LAS f16x8*)(dts + (32 * th + l31) * DT_PITCH + 64 * g + 16 * s + 8 * hi);
            const size_t tok = (size_t)(tok0 + 32 * th + l31);
#pragma unroll
            for (int cb = 0; cb < 2; ++cb) {
                f32x16 acc;
#pragma unroll
                for (int r = 0; r < 16; ++r) acc[r] = 0.f;
#pragma unroll
                for (int s = 0; s < 4; ++s) { const f16x8 wf = *(const f16x8*)(WpT + ((size_t)(g * 64 + 32 * cb + l31) * 64 + 16 * s + 8 * hi)); acc = __builtin_amdgcn_mfma_f32_32x32x16_f16(wf, Bf[s], acc, 0, 0, 0); }
#pragma unroll
                for (int rg = 0; rg < 4; ++rg) {
                    const int j0 = 32 * cb + 8 * rg + 4 * hi;
                    const f32x4 sc = *(const f32x4*)(pool_scale + 64 * g + j0);
                    u32x2 o; o.x = pk_f16(acc[4 * rg] * sc[0], acc[4 * rg + 1] * sc[1]); o.y = pk_f16(acc[4 * rg + 2] * sc[2], acc[4 * rg + 3] * sc[3]);
                    *(u32x2*)(mixed + tok * D + DRNN + 64 * g + j0) = o;
                }
            }
        }
        if (sub & 4) {
            float ga = 1.f, gh = 0.f;
            if (gi != 15) lookback16(agc + (size_t)gbase * DRNN, gi, la, lh);
            lookback16(AGG2 + (size_t)((ch / (SEQ / 64)) * 8) * DRNN + lane + 64 * w, grp, ga, gh);
            const float carry = la * gh + lh;
            const float carry0 = __shfl(carry, l31), carry1 = __shfl(carry, 32 + l31);
            LAS f16* stg = (LAS f16*)(F.lds + P2_STG_OFF + w * 4096);
#pragma unroll 1
            for (int it = 0; it < 4; ++it) {
                const int cb = it >> 1, tb = it & 1;
                const float cy = cb ? carry1 : carry0;
#pragma unroll
                for (int q = 0; q < 8; ++q) {
                    const f16x2 h2 = __builtin_bit_cast(f16x2, sth_[3][q]), p2 = __builtin_bit_cast(f16x2, stp_[3][q]);
                    const int r0 = 2 * q, r1 = 2 * q + 1;
                    stg[(4 * hi + (r0 & 3) + 8 * (r0 >> 2)) * 32 + l31] = (f16)((float)h2[0] + (float)p2[0] * cy);
                    stg[(4 * hi + (r1 & 3) + 8 * (r1 >> 2)) * 32 + l31] = (f16)((float)h2[1] + (float)p2[1] * cy);
                }
#pragma unroll
                for (int q = 0; q < 8; ++q) { sth_[3][q] = sth_[2][q]; sth_[2][q] = sth_[1][q]; sth_[1][q] = sth_[0][q]; stp_[3][q] = stp_[2][q]; stp_[2][q] = stp_[1][q]; stp_[1][q] = stp_[0][q]; }
                const int tk = lane >> 1, sg2 = lane & 1;
                const u32x4 h0 = *(const LAS u32x4*)(stg + tk * 32 + 8 * sg2), h1 = *(const LAS u32x4*)(stg + tk * 32 + 16 + 8 * sg2);
                const size_t go = (size_t)(tok0 + 32 * tb + tk) * D + 64 * w + 32 * cb + 8 * sg2;
                *(u32x4*)(mixed + go) = h0; *(u32x4*)(mixed + go + 16) = h1;
            }
        }
        if (sub & 16) {
            __syncthreads();
            {
                const char* ksrc = (const char*)(Kh + (size_t)b * NMEM * DX);
#pragma unroll
                for (int j = 0; j < 16; ++j) {
                    const int Pq = tid + 512 * j, key = Pq >> 5, pr = Pq & 31, hd = pr >> 3, chn = pr & 7;
                    const u32x4 v = *(const u32x4*)(ksrc + (size_t)Pq * 16);
                    *(LAS u32x4*)(F.lds + hd * 32768 + key * 128 + ((chn ^ (key & 7)) << 4)) = v;
                }
            }
            const int h = w >> 1, th = w & 1;
            const char* qb = (const char*)(proj + (size_t)(tok0 + 32 * th) * DIN + 2 * DRNN + DPOOL + 64 * h);
            const unsigned qoff = (unsigned)(l31 * DIN + 8 * hi) * 2u;
            f16x8 Qf[4];
#pragma unroll
            for (int s = 0; s < 4; ++s) Qf[s] = *(const f16x8*)(qb + 32 * s + (size_t)qoff);
            const char* vbase = (const char*)(VT + (size_t)b * DX * NMEM + (size_t)(64 * h) * NMEM);
            const unsigned voff = (unsigned)(l31 * NMEM + 8 * hi) * 2u;
            const float scl = 0.125f * LOG2E;
            __syncthreads();
            const LAS unsigned char* kl = F.lds + h * 32768 + l31 * 128;
            const int ksw = l31 & 7;
            float m = -INFINITY;
#pragma unroll 2
            for (int kb = 0; kb < 8; ++kb) {
                f32x16 acc;
#pragma unroll
                for (int r = 0; r < 16; ++r) acc[r] = 0.f;
#pragma unroll
                for (int s = 0; s < 4; ++s) { const f16x8 kfr = *(const LAS f16x8*)(kl + kb * 4096 + (((2 * s + hi) ^ ksw) << 4)); acc = __builtin_amdgcn_mfma_f32_32x32x16_f16(kfr, Qf[s], acc, 0, 0, 0); }
#pragma unroll
                for (int r = 0; r < 16; ++r) m = fmaxf(m, acc[r]);
            }
            m = fmaxf(m, __shfl_xor(m, 32));
            float sum = 0.f;
            f32x16 O[2];
#pragma unroll
            for (int db = 0; db < 2; ++db)
#pragma unroll
                for (int r = 0; r < 16; ++r) O[db][r] = 0.f;
            u32x4 va[2][2], vb2[2][2];
#define LOADV(dst, kb_) do { _Pragma("unroll") for (int s2 = 0; s2 < 2; ++s2) _Pragma("unroll") for (int db = 0; db < 2; ++db) { \
                const char* vp = vbase + (32 * db * NMEM + 32 * (kb_) + 16 * s2) * 2 + (size_t)voff; dst[s2][db] = *(const u32x4*)vp; } } while (0)
            LOADV(va, 0); LOADV(vb2, 1);
#pragma unroll 1
            for (int kb = 0; kb < 8; kb += 2) {
#pragma unroll
                for (int half2 = 0; half2 < 2; ++half2) {
                    const int kbb = kb + half2;
                    f32x16 acc;
#pragma unroll
                    for (int r = 0; r < 16; ++r) acc[r] = 0.f;
#pragma unroll
                    for (int s = 0; s < 4; ++s) { const f16x8 kfr = *(const LAS f16x8*)(kl + kbb * 4096 + (((2 * s + hi) ^ ksw) << 4)); acc = __builtin_amdgcn_mfma_f32_32x32x16_f16(kfr, Qf[s], acc, 0, 0, 0); }
#pragma unroll
                    for (int s2 = 0; s2 < 2; ++s2) {
                        f16x8 pf;
#pragma unroll
                        for (int j = 0; j < 8; ++j) { const float p = __builtin_amdgcn_exp2f((acc[8 * s2 + j] - m) * scl); sum += p; pf[j] = (f16)p; }
#pragma unroll
                        for (int db = 0; db < 2; ++db) {
                            const u32x4 vr = half2 ? vb2[s2][db] : va[s2][db];
                            const auto s0_ = __builtin_amdgcn_permlane32_swap(vr.x, vr.z, false, false), s1_ = __builtin_amdgcn_permlane32_swap(vr.y, vr.w, false, false);
                            u32x4 vq; vq.x = s0_[0]; vq.y = s1_[0]; vq.z = s0_[1]; vq.w = s1_[1];
                            const f16x8 vf = __builtin_bit_cast(f16x8, vq);
                            O[db] = __builtin_amdgcn_mfma_f32_32x32x16_f16(vf, pf, O[db], 0, 0, 0);
                        }
                    }
                    if (half2 == 0) { const int kn = (kb + 2 < 8) ? kb + 2 : 7; LOADV(va, kn); } else { const int kn = (kb + 3 < 8) ? kb + 3 : 7; LOADV(vb2, kn); }
                }
            }
#undef LOADV
            sum += __shfl_xor(sum, 32);
            const float inv = 1.f / sum;
            f16* orow = mixed + (size_t)(tok0 + 32 * th + l31) * D + DRNN + DPOOL + 64 * h + 4 * hi;
#pragma unroll
            for (int db = 0; db < 2; ++db)
#pragma unroll
                for (int rg = 0; rg < 4; ++rg) { u32x2 o; o.x = pk_f16(O[db][4 * rg] * inv, O[db][4 * rg + 1] * inv); o.y = pk_f16(O[db][4 * rg + 2] * inv, O[db][4 * rg + 3] * inv); *(u32x2*)(orow + 32 * db + 8 * rg) = o; }
        }
        asm volatile("s_waitcnt vmcnt(0)" ::: "memory");
        __syncthreads();
    }
}

__device__ __forceinline__ void p5_route(Frame& F) {
    const float* PARTL = (const float*)(F.ws + WS_PARTL); const float* SSQP = (const float*)(F.ws + WS_SSQP); const float* b_r = F.in[18];
    int* list = (int*)(F.ws + WS_LIST); float* glist = (float*)(F.ws + WS_GLIST); float* rlist = (float*)(F.ws + WS_RLIST);
    LAS float* lg = (LAS float*)(F.lds);
    LAS float* rs = (LAS float*)(F.lds + 8448);
    LAS int* sel_e = (LAS int*)(F.lds + 8704);
    LAS int* sel_r = (LAS int*)(F.lds + 9728);
    LAS float* sel_g = (LAS float*)(F.lds + 10752);
    LAS int* lcnt = (LAS int*)(F.lds + 11776);
    LAS int* lbase = (LAS int*)(F.lds + 11904);
    const int w = F.wave, lane = F.lane;
    for (int ch = F.bx; ch < T / 64; ch += F.G) {
        const int tok0 = ch * 64;
        if (F.tid < 32) lcnt[F.tid] = 0;
        {
            const int token = F.tid >> 3, e4 = (F.tid & 7) * 4;
            f32x4 sum = *(const f32x4*)(PARTL + (size_t)(tok0 + token) * 32 + e4); float ss = SSQP[tok0 + token];
#pragma unroll
            for (int pn = 1; pn < 4; ++pn) { sum += *(const f32x4*)(PARTL + ((size_t)pn * T + tok0 + token) * 32 + e4); ss += SSQP[(size_t)pn * T + tok0 + token]; }
            const float rstd = rsqrtf(ss * (1.f / D) + EPS);
            const f32x4 bb = *(const f32x4*)(b_r + e4);
#pragma unroll
            for (int j = 0; j < 4; ++j) lg[token * 33 + e4 + j] = sum[j] * (rstd * (1.f / 1024.f)) + bb[j];
            if ((F.tid & 7) == 0) rs[token] = rstd;
        }
        __syncthreads();
#pragma unroll 1
        for (int p = 0; p < 4; ++p) {
            const int token = 16 * p + 2 * w + (lane >> 5), le = lane & 31;
            float v = lg[token * 33 + le];
            int idx[4]; float val[4];
#pragma unroll
            for (int k = 0; k < 4; ++k) {
                float mx = v;
#pragma unroll
                for (int o = 1; o < 32; o <<= 1) mx = fmaxf(mx, __shfl_xor(mx, o));
                const unsigned long long bal = __ballot(v == mx);
                const unsigned half = (unsigned)(bal >> (lane & 32));
                const int bi = __builtin_ctz(half);
                idx[k] = bi; val[k] = mx;
                if (le == bi) v = -INFINITY;
            }
            if (le == 0) {
                float es[4], sum = 0.f;
#pragma unroll
                for (int k = 0; k < 4; ++k) { es[k] = __expf(val[k] - val[0]); sum += es[k]; }
                const float inv = 1.f / sum;
#pragma unroll
                for (int k = 0; k < 4; ++k) { const int sl = token * 4 + k; sel_e[sl] = idx[k]; sel_g[sl] = es[k] * inv; sel_r[sl] = atomicAdd((int*)&lcnt[idx[k]], 1); }
            }
        }
        __syncthreads();
        if (F.tid < 32) { const int n = lcnt[F.tid]; lbase[F.tid] = n ? (int)atomicAdd(&F.ctl[CW_COUNTS + 64 * F.tid], (unsigned)n) : 0; }
        __syncthreads();
        if (F.tid < 256) { const int e = sel_e[F.tid]; const int li = e * T + lbase[e] + sel_r[F.tid]; list[li] = (tok0 + (F.tid >> 2)) * 4 + (F.tid & 3); glist[li] = sel_g[F.tid]; rlist[li] = rs[F.tid >> 2]; }
        __syncthreads();
    }
}

__device__ __forceinline__ void p8_final(Frame& F) {
    const f16* x1 = (const f16*)(F.ws + WS_X1); const unsigned char* Y = F.ws + WS_Y; const float* g = F.in[23];
    float* out = (float*)F.out;
    const int gw = F.vcu * NWAVES + F.wave, NGW = F.G * NWAVES, lane = F.lane;
    const int per = (T + NGW - 1) / NGW;
    f32x4 gg[4];
#pragma unroll
    for (int j = 0; j < 4; ++j) gg[j] = ((const f32x4*)g)[lane + 64 * j];
    for (int t0 = gw * per; t0 < (gw + 1) * per && t0 < T; t0 += 4) {
        f16x4 xh[4][4]; int yv[4][4][4];
#pragma unroll
        for (int q = 0; q < 4; ++q) {
            const int tok = (t0 + q < T) ? t0 + q : T - 1;
#pragma unroll
            for (int j = 0; j < 4; ++j) {
                xh[q][j] = ((const f16x4*)(x1 + (size_t)tok * D))[lane + 64 * j];
#pragma unroll
                for (int k = 0; k < 4; ++k) yv[q][j][k] = __builtin_nontemporal_load((const int*)(Y + (size_t)(tok * 4 + k) * D + 4 * (lane + 64 * j)));
            }
        }
#pragma unroll
        for (int q = 0; q < 4; ++q) {
            f32x4 v[4]; float s = 0.f;
#pragma unroll
            for (int j = 0; j < 4; ++j) {
                f32x4 a = {(float)xh[q][j][0], (float)xh[q][j][1], (float)xh[q][j][2], (float)xh[q][j][3]};
#pragma unroll
                for (int k = 0; k < 4; ++k) { const f32x2 lo = __builtin_amdgcn_cvt_pk_f32_fp8(yv[q][j][k], false), hi2 = __builtin_amdgcn_cvt_pk_f32_fp8(yv[q][j][k], true);
                    a[0] += lo[0] * (1.f / SC_Y); a[1] += lo[1] * (1.f / SC_Y); a[2] += hi2[0] * (1.f / SC_Y); a[3] += hi2[1] * (1.f / SC_Y); }
                v[j] = a; s += (a[0] * a[0] + a[1] * a[1]) + (a[2] * a[2] + a[3] * a[3]);
            }
            s = wave_sum(s);
            const float r = rsqrtf(s * (1.f / D) + EPS);
            if (t0 + q < T && t0 + q < (gw + 1) * per) {
#pragma unroll
                for (int j = 0; j < 4; ++j) __builtin_nontemporal_store(v[j] * r * gg[j], (f32x4*)(out + (size_t)(t0 + q) * D) + lane + 64 * j);
            }
        }
    }
}

constexpr int NPHASE = 9;
__global__ void __launch_bounds__(NWAVES * 64, 2) mega(Params P) {
    extern __shared__ __attribute__((aligned(16))) unsigned char lds_raw[];
    Frame F;
    F.lds = (LAS unsigned char*)lds_raw;
    F.tid = threadIdx.x; F.lane = F.tid & 63; F.wave = __builtin_amdgcn_readfirstlane(F.tid >> 6);
    F.G = gridDim.x; F.bx = blockIdx.x; F.vcu = (F.G % 8 == 0) ? (F.bx % 8) * (F.G / 8) + F.bx / 8 : F.bx;
    F.ws = P.ws; F.ctl = (unsigned*)(P.ws + WS_CTL); F.in = P.in; F.out = P.out; F.flags = P.flags;
    for (int u = F.tid; u < (LDS_BYTES - LDS_CTL_OFF) / 4; u += NWAVES * 64) ((LAS unsigned*)(F.lds + LDS_CTL_OFF))[u] = 0u;
    __syncthreads();
    const int lo = P.ph_lo, hi = P.ph_hi;
    XcdBarrier bar; bar.bar = F.ctl + CW_BAR; bar.x = 0; bar.st = nullptr;
    if (hi - lo > 1) bar = xcd_barrier_post(F.ctl + CW_BAR, (volatile LAS unsigned*)(F.lds + LDS_CTL_OFF + 32));
#define IN(k) (lo <= (k) && (k) < hi)
#define SEAM(k) do { if (IN(k) && IN((k) + 1)) xcd_barrier(bar); } while (0)
    if (IN(0)) { p0_prologue(F); p0_small(F); SEAM(0); }
    if (IN(1)) {
        SchedP1 S{(const char*)(F.ws + WS_H0), (const char*)(F.ws + WS_WINT), (const char*)(F.ws + WS_MEMN), (const char*)(F.ws + WS_WKVT), F.G, F.bx};
        EpiP1 E{(f16*)(F.ws + WS_PROJ), (f16*)(F.ws + WS_KH), (f16*)(F.ws + WS_VT)};
        pg::gemm_phase(F.lds, S, E);
        p1_deferred_items(F);
        SEAM(1);
    }
    if (IN(2)) { p2_mixer(F); if (!IN(3)) {} }
    if (IN(3)) { SEAM(3); }
    if (IN(4)) {
        EpiP3 E{F.in[0], (f16*)(F.ws + WS_X1), F.ws + WS_X1N, F.in[16], (const f16*)(F.ws + WS_SMALLW + SW_WRP), (float*)(F.ws + WS_PARTL), (float*)(F.ws + WS_SSQP), F.lds};
        for (int L = F.bx; L < 64 * 4; L += F.G) { SchedP3 S{(const char*)(F.ws + WS_MIXED), (const char*)(F.ws + WS_WOUTT), L}; pg::gemm_phase(F.lds, S, E); }
        SEAM(4);
    }
    if (IN(5)) { p5_route(F); SEAM(5); }
    if (IN(6)) {
        moe_table(F);
        SchedMoe<8, true> S{(const char*)(F.ws + WS_X1N), (const char*)(F.ws + WS_WGUT), (size_t)2 * DFF * pg::ROWB8, (const int*)(F.ws + WS_LIST), (const LAS int*)(F.lds + LDS_CTL_OFF + 256), F.G, F.bx};
        EpiGU E{F.in[20], (const float*)(F.ws + WS_RLIST), (unsigned char*)(F.ws + WS_HBUF), F.flags & 1};
        pg::gemm_phase(F.lds, S, E);
        SEAM(6);
    }
    if (IN(7)) {
        moe_table(F);
        SchedMoe<4, false> S{(const char*)(F.ws + WS_HBUF), (const char*)(F.ws + WS_WDT), (size_t)D * pg::ROWB8, (const int*)(F.ws + WS_LIST), (const LAS int*)(F.lds + LDS_CTL_OFF + 256), F.G, F.bx};
        EpiDown E{F.in[22], (const int*)(F.ws + WS_LIST), (const float*)(F.ws + WS_GLIST), (unsigned char*)(F.ws + WS_Y), F.flags & 1};
        pg::gemm_phase(F.lds, S, E);
        SEAM(7);
    }
    if (IN(8)) { p8_final(F); }
#undef IN
#undef SEAM
}
}

extern "C" void kernel_launch(void* const* d_in, const int* in_sizes, int n_in, void* d_out, int out_size, void* d_ws, size_t ws_size, hipStream_t stream) {
    static int grid = 0;
    if (grid == 0) {
        if (n_in != 24 || ws_size < WS_END) { fprintf(stderr, "kernel_launch: unexpected n_in %d / ws %zu\n", n_in, ws_size); grid = -1; return; }
        int dev = 0, cus = 0;
        (void)hipGetDevice(&dev); (void)hipDeviceGetAttribute(&cus, hipDeviceAttributeMultiprocessorCount, dev);
        if (hipFuncSetAttribute((const void*)mega, hipFuncAttributeMaxDynamicSharedMemorySize, LDS_BYTES) != hipSuccess) { fprintf(stderr, "kernel_launch: hipFuncSetAttribute failed\n"); grid = -1; return; }
        int per_cu = 0;
        if (hipOccupancyMaxActiveBlocksPerMultiprocessor(&per_cu, (const void*)mega, NWAVES * 64, LDS_BYTES) != hipSuccess || per_cu < 1) fprintf(stderr, "kernel_launch: occupancy query says %d\n", per_cu);
        (void)hipGetLastError();
        grid = cus;
        if (grid % 8 != 0) fprintf(stderr, "kernel_launch: grid %d not a multiple of 8\n", grid);
    }
    if (grid < 0) return;
    unsigned char* ws = (unsigned char*)d_ws;
    (void)hipMemsetAsync(ws + WS_CTL, 0, 32768, stream);
    Params p{};
    for (int i = 0; i < 24; ++i) p.in[i] = (const float*)d_in[i];
    p.out = (float*)d_out; p.ws = ws;
    p.ph_lo = 0; p.ph_hi = NPHASE;
    hipLaunchKernelGGL(mega, dim3(grid), dim3(NWAVES * 64), LDS_BYTES, stream, p);
}
```

```cpp
#include <hip/hip_runtime.h>
#include <cstdio>
#include <cstdint>


namespace {
constexpr int BATCH = 2, SEQ = 8192, D = 1024, T = BATCH * SEQ, NMEM = 256;
constexpr int DRNN = 512, NH = 8, DPOOL = 256, DX = 256, XH = 4, DIN = 1536;
constexpr int NE = 32, TOPK = 4, DFF = 1024, TK = T * TOPK;
constexpr float EPS = 1e-6f;
typedef _Float16 f16;
typedef _Float16 f16x2 __attribute__((ext_vector_type(2)));
typedef _Float16 f16x4 __attribute__((ext_vector_type(4)));
typedef _Float16 f16x8 __attribute__((ext_vector_type(8)));
typedef float f32x2 __attribute__((ext_vector_type(2)));
typedef float f32x4 __attribute__((ext_vector_type(4)));
typedef unsigned u32x4 __attribute__((ext_vector_type(4)));
typedef unsigned u32x2 __attribute__((ext_vector_type(2)));
#define LAS __attribute__((address_space(3)))

constexpr size_t MiB = 1u << 20;
constexpr size_t WS_CTL = 0;
constexpr size_t WS_LIST = 1 * MiB;
constexpr size_t WS_TOPE = 3 * MiB;
constexpr size_t WS_TOPG = 3 * MiB + 512 * 1024;
constexpr size_t WS_SMALLW = 4 * MiB;
constexpr size_t WS_WKVT = 5 * MiB;
constexpr size_t WS_MEMN = 6 * MiB;
constexpr size_t WS_KH = 7 * MiB;
constexpr size_t WS_VT = 7 * MiB + 512 * 1024;
constexpr size_t WS_WINT = 8 * MiB;
constexpr size_t WS_WOUTT = 11 * MiB;
constexpr size_t WS_AGG = 13 * MiB;
constexpr size_t WS_KVF = 14 * MiB;
constexpr size_t WS_GLIST = 14 * MiB;
constexpr size_t WS_WGUT = 16 * MiB;
constexpr size_t WS_WDT = 144 * MiB;
constexpr size_t WS_H0 = 208 * MiB;
constexpr size_t WS_PROJ = 240 * MiB;
constexpr size_t WS_PARTL = 288 * MiB;
constexpr size_t WS_SSQP = 296 * MiB;
constexpr size_t WS_RSTD0 = 300 * MiB;
constexpr size_t WS_RLIST = 297 * MiB;
constexpr size_t WS_MIXED = 352 * MiB;
constexpr size_t WS_X1 = 384 * MiB;
constexpr size_t WS_X1N = 448 * MiB;
constexpr size_t WS_HBUF = 482 * MiB;
constexpr size_t WS_Y = 626 * MiB;
constexpr size_t WS_END = 756 * MiB;
constexpr int CW_COUNTS = 0;
constexpr int CW_BAR = 4096;

struct Params {
    const float* in[24];
    float* out;
    unsigned char* ws;
    int ph_lo, ph_hi, flags, pad;
};

__device__ __forceinline__ float wave_sum(float v) {
#pragma unroll
    for (int o = 1; o < 64; o <<= 1) v += __shfl_xor(v, o);
    return v;
}
__device__ __forceinline__ float sigmoidf_(float x) { return 1.f / (1.f + expf(-x)); }
__device__ __forceinline__ unsigned pk_f16(float lo, float hi) { f32x2 v = {lo, hi}; f16x2 h = __builtin_convertvector(v, f16x2); return __builtin_bit_cast(unsigned, h); }
constexpr float SC_W = 64.f, SC_X = 16.f, SC_H = 4.f, SC_Y = 16.f;
__device__ __forceinline__ unsigned pk4_fp8(float a, float b, float c, float d) { int r = __builtin_amdgcn_cvt_pk_fp8_f32(a, b, 0, false); r = __builtin_amdgcn_cvt_pk_fp8_f32(c, d, r, true); return (unsigned)r; }
__device__ __forceinline__ float4 load4(const float* p) { return *(const float4*)p; }
__device__ __forceinline__ float4 load4(const f16* p) { const f16x4 h = *(const f16x4*)p; return make_float4((float)h[0], (float)h[1], (float)h[2], (float)h[3]); }
__device__ __forceinline__ void store4(float* p, float4 v) { *(float4*)p = v; }
__device__ __forceinline__ void store4(f16* p, float4 v) { u32x2 w; w.x = pk_f16(v.x, v.y); w.y = pk_f16(v.z, v.w); *(u32x2*)p = w; }
__device__ __forceinline__ int gu_dest_row(int n) { return n < DFF ? ((n >> 7) * 256 + (n & 127)) : (((n - DFF) >> 7) * 256 + 128 + ((n - DFF) & 127)); }

namespace pg {
constexpr int LDS_EPI = 139264 + 8192;
constexpr int LDS_PF_OFF = 139264 + 4096;
constexpr int BM = 256, BK = 64, HALF = 128, HTB = HALF * BK * 2, STAGE_BYTES = 8 * HTB, KD = 1024, NT = KD / BK;
constexpr unsigned ROWB = KD * 2;
constexpr unsigned ROWB8 = KD;
typedef int i32x8 __attribute__((ext_vector_type(8)));
__host__ __device__ __forceinline__ int lds_byte(int r, int c) { const int st = (r >> 4) * 2 + (c >> 5), rr = r & 15, cc = c & 31, ob = rr * 64 + cc * 2; return st * 1024 + (ob ^ (((ob >> 9) & 1) << 5)); }
__host__ __device__ __forceinline__ void stage_rc(int b, int& R, int& C) { const int st = b / 1024, sb = b % 1024, swz = sb ^ (((sb >> 9) & 1) << 5); R = (st >> 1) * 16 + swz / 64; C = (st & 1) * 32 + (swz % 64) / 2; }
__host__ __device__ __forceinline__ int perm32(int rho) { const int n = rho >> 4, i = rho & 15; return 8 * (i >> 2) + 4 * n + (i & 3); }

struct Unit { const char* A; const char* B; int kind, pm, pn, e, p0, cnt, hrow; };

__device__ __forceinline__ void glds16(const void* sbase, unsigned voff, unsigned lds_dst) {
    unsigned keep;
    asm volatile("s_mov_b32 %0, m0\n\ts_mov_b32 m0, %3\n\ts_nop 0\n\tglobal_load_lds_dwordx4 %1, %2\n\ts_mov_b32 m0, %0"
                 : "=&s"(keep) : "v"(voff), "s"(sbase), "s"(lds_dst) : "memory");
}
__device__ __forceinline__ const char* uptr(const char* p) {
    const unsigned long long v = (unsigned long long)(size_t)p;
    const unsigned lo = __builtin_amdgcn_readfirstlane((unsigned)v), hi = __builtin_amdgcn_readfirstlane((unsigned)(v >> 32));
    return (const char*)(size_t)(((unsigned long long)hi << 32) | lo);
}
__device__ __forceinline__ void glds4_prefetch(const void* sbase, unsigned voff, unsigned lds_dst) {
    unsigned keep;
    asm volatile("s_nop 4\n\ts_mov_b32 %0, m0\n\ts_mov_b32 m0, %3\n\ts_nop 0\n\tglobal_load_lds_dword %1, %2\n\ts_mov_b32 m0, %0"
                 : "=&s"(keep) : "v"(voff), "s"(sbase), "s"(lds_dst) : "memory");
}
__device__ __forceinline__ void glds16n(const void* sbase, unsigned voff, unsigned lds_dst) {
    unsigned keep;
    asm volatile("s_nop 4\n\ts_mov_b32 %0, m0\n\ts_mov_b32 m0, %3\n\ts_nop 0\n\tglobal_load_lds_dwordx4 %1, %2\n\ts_mov_b32 m0, %0"
                 : "=&s"(keep) : "v"(voff), "s"(sbase), "s"(lds_dst) : "memory");
}
template <class Sched, class Epi>
__device__ __forceinline__ void gemm_phase(LAS unsigned char* lds, const Sched& S, const Epi& E) {
    constexpr bool FP8 = Epi::FP8, GATHER = Sched::GATHER;
    constexpr unsigned ROWB_ = FP8 ? ROWB8 : ROWB;
    constexpr int NT_ = FP8 ? (KD / 128) : (KD / BK);
    const int tid = threadIdx.x, wid = __builtin_amdgcn_readfirstlane(tid >> 6), lane = tid & 63, wr = wid >> 2, wc = wid & 3, fr = lane & 15, fq = lane >> 4;
    int R0, C0; stage_rc(tid * 16, R0, C0);
    const unsigned colb = (unsigned)C0 * 2u;
    const unsigned voffA0 = (unsigned)R0 * ROWB_ + colb;
    const unsigned voffB0 = (unsigned)(Epi::PERM ? ((R0 & ~31) + perm32(R0 & 31)) : R0) * ROWB_ + colb;
    unsigned arow[4], arowN[4];
    const size_t kstep = (size_t)(BK * 2);
    const size_t hstepB = (size_t)HALF * ROWB_, qstep = (size_t)64 * ROWB_;
    const unsigned ldsb = (unsigned)(size_t)lds + (unsigned)wid * 1024u;
    const int aoff = lds_byte(wr * 64 + fr, fq * 8), boff = lds_byte(wc * 32 + fr, fq * 8);
#define PG_SA(b, h) (((b) * 2 + (h)) * HTB)
#define PG_SB(b, h) ((4 + (b) * 2 + (h)) * HTB)
#define PG_STAGEB(bufoff, gbase) do { glds16((const char*)(gbase), voffB0, ldsb + (bufoff)); glds16((const char*)(gbase) + qstep, voffB0, ldsb + (bufoff) + 8192); } while (0)
#define PG_STAGEA(bufoff, gbase, r0_, r1_, h) do { \
        if constexpr (GATHER) { glds16((const char*)(gbase), (r0_), ldsb + (bufoff)); glds16((const char*)(gbase), (r1_), ldsb + (bufoff) + 8192); } \
        else { glds16((const char*)(gbase) + (2 * (h)) * qstep, voffA0, ldsb + (bufoff)); glds16((const char*)(gbase) + (2 * (h) + 1) * qstep, voffA0, ldsb + (bufoff) + 8192); } } while (0)
#define PG_LDA(dst, b, h) do { _Pragma("unroll") for (int m = 0; m < 4; ++m) { \
        if constexpr (FP8) { const u32x4 lo_ = *(const LAS u32x4*)(lds + PG_SA(b, h) + aoff + m * 2048), hi_ = *(const LAS u32x4*)(lds + PG_SA(b, h) + aoff + m * 2048 + 1024); dst##8[m] = __builtin_shufflevector(lo_, hi_, 0, 1, 2, 3, 4, 5, 6, 7); } \
        else { _Pragma("unroll") for (int k = 0; k < 2; ++k) dst[m][k] = *(const LAS f16x8*)(lds + PG_SA(b, h) + aoff + m * 2048 + k * 1024); } } } while (0)
#define PG_LDB(dst, b, h) do { _Pragma("unroll") for (int n = 0; n < 2; ++n) { \
        if constexpr (FP8) { const u32x4 lo_ = *(const LAS u32x4*)(lds + PG_SB(b, h) + boff + n * 2048), hi_ = *(const LAS u32x4*)(lds + PG_SB(b, h) + boff + n * 2048 + 1024); dst##8[n] = __builtin_shufflevector(lo_, hi_, 0, 1, 2, 3, 4, 5, 6, 7); } \
        else { _Pragma("unroll") for (int k = 0; k < 2; ++k) dst[n][k] = *(const LAS f16x8*)(lds + PG_SB(b, h) + boff + n * 2048 + k * 1024); } } } while (0)
#define PG_MMA(ai, bj, At, Bt) do { __builtin_amdgcn_s_setprio(1); _Pragma("unroll") for (int m = 0; m < 4; ++m) _Pragma("unroll") for (int n = 0; n < 2; ++n) { \
        if constexpr (FP8) asm volatile("v_mfma_scale_f32_16x16x128_f8f6f4 %0, %1, %2, %0, %3, %3 op_sel_hi:[0,0,0]" : "+v"(acc[ai][bj][m][n]) : "v"(Bt##8[n]), "v"(At##8[m]), "v"(mxscale)); \
        else { _Pragma("unroll") for (int k = 0; k < 2; ++k) acc[ai][bj][m][n] = __builtin_amdgcn_mfma_f32_16x16x32_f16(Bt[n][k], At[m][k], acc[ai][bj][m][n], 0, 0, 0); } } \
        __builtin_amdgcn_s_setprio(0); } while (0)
#define PG_WAIT_V(n) asm volatile("s_waitcnt vmcnt(" #n ")" ::: "memory")
#define PG_WAIT_L(n) asm volatile("s_waitcnt lgkmcnt(" #n ")" ::: "memory")
#define PG_BAR __builtin_amdgcn_s_barrier()
#define PG_SCHED __builtin_amdgcn_sched_barrier(0)
    Unit cur, nxt; int ui = 0;
    if (!S.next(0, cur)) return;
    if constexpr (GATHER) S.rows(cur, R0, colb, arow);
    f32x4 acc[2][2][4][2];
    f16x8 At[4][2], B0[2][2], B1[2][2];
    typedef unsigned u32x8 __attribute__((ext_vector_type(8)));
    u32x8 At8[4], B08[2], B18[2];
    unsigned mxscale = 0x7F7F7F7Fu; asm volatile("" : "+v"(mxscale));
    const char* cA = cur.A; const char* cB = cur.B;
    PG_WAIT_V(0);
    E.init(acc, cur, wr, wc, fr, fq);
    E.prefetch(cur, wid, lane, (unsigned)(size_t)lds + (unsigned)LDS_EPI);
    PG_STAGEB(PG_SB(0, 0), cB); PG_STAGEB(PG_SB(0, 1), cB + hstepB); PG_STAGEA(PG_SA(0, 0), cA, arow[0], arow[1], 0); PG_STAGEA(PG_SA(0, 1), cA, arow[2], arow[3], 1);
    if (wr == 1) PG_BAR;
    PG_WAIT_V(2); PG_BAR;
    PG_STAGEB(PG_SB(1, 0), cB + kstep); PG_STAGEA(PG_SA(1, 0), cA + kstep, arow[0], arow[1], 0); PG_STAGEB(PG_SB(1, 1), cB + hstepB + kstep);
    PG_WAIT_V(6); PG_BAR;
#pragma unroll
    for (int a = 0; a < 2; ++a)
#pragma unroll
        for (int b = 0; b < 2; ++b)
            asm volatile("" : "+v"(acc[a][b][0][0]), "+v"(acc[a][b][0][1]), "+v"(acc[a][b][1][0]), "+v"(acc[a][b][1][1]), "+v"(acc[a][b][2][0]), "+v"(acc[a][b][2][1]), "+v"(acc[a][b][3][0]), "+v"(acc[a][b][3][1]));
    for (;;) {
        const bool has_next = S.next(ui + 1, nxt);
        const char* nA = has_next ? nxt.A : cA; const char* nB = has_next ? nxt.B : cB;
        const int hf_ = Sched::HALVES ? __builtin_amdgcn_readfirstlane(cur.kind) : 0;
        unsigned rawN[4];
        if constexpr (GATHER) {
            if (has_next) S.rows_issue(nxt, R0, rawN);
            else {
#pragma unroll
                for (int q = 0; q < 4; ++q) arowN[q] = arow[q];
            }
        }
#pragma unroll 1
        for (int t = 0; t < NT_; t += 2) {
            const bool last = (t == NT_ - 2);
            if (t == 2 && has_next) E.prefetch(nxt, wid, lane, (unsigned)(size_t)lds + (unsigned)LDS_EPI + (unsigned)(((ui + 1) & 1) * 4096));
            if constexpr (GATHER) {
                if (last && has_next) {
                    asm volatile("s_waitcnt vmcnt(8)" : "+v"(rawN[0]), "+v"(rawN[1]), "+v"(rawN[2]), "+v"(rawN[3]) :: "memory");
                    S.rows_finish(nxt, R0, colb, rawN, arowN);
                }
            }
            const char* a1 = cA + (size_t)(t + 1) * kstep;
            const char* a2 = last ? nA : cA + (size_t)(t + 2) * kstep; const char* b2 = last ? nB : cB + (size_t)(t + 2) * kstep;
            const char* a3 = a2 + kstep; const char* b3 = b2 + kstep;
            PG_LDB(B0, 0, 0); PG_LDB(B1, 0, 1); PG_SCHED; PG_LDA(At, 0, 0); PG_STAGEA(PG_SA(1, 1), a1, arow[2], arow[3], 1);
            PG_WAIT_V(8); PG_WAIT_L(0); PG_BAR; if (!Sched::HALVES || hf_ != 2) { PG_MMA(0, 0, At, B0); PG_MMA(0, 1, At, B1); } PG_BAR; PG_SCHED;
            PG_LDA(At, 0, 1); PG_STAGEB(PG_SB(0, 0), b2); PG_STAGEB(PG_SB(0, 1), b2 + hstepB); PG_STAGEA(PG_SA(0, 0), a2, (last ? arowN[0] : arow[0]), (last ? arowN[1] : arow[1]), 0);
            PG_WAIT_V(8); PG_WAIT_L(0); PG_BAR; if (!Sched::HALVES || hf_ != 1) { PG_MMA(1, 0, At, B0); PG_MMA(1, 1, At, B1); } PG_BAR; PG_SCHED;
            PG_LDB(B0, 1, 0); PG_LDB(B1, 1, 1); PG_SCHED; PG_LDA(At, 1, 0); PG_STAGEA(PG_SA(0, 1), a2, (last ? arowN[2] : arow[2]), (last ? arowN[3] : arow[3]), 1);
            PG_WAIT_V(8); PG_WAIT_L(0); PG_BAR; if (!Sched::HALVES || hf_ != 2) { PG_MMA(0, 0, At, B0); PG_MMA(0, 1, At, B1); } PG_BAR; PG_SCHED;
            PG_LDA(At, 1, 1); PG_STAGEB(PG_SB(1, 0), b3); PG_STAGEB(PG_SB(1, 1), b3 + hstepB); PG_STAGEA(PG_SA(1, 0), a3, (last ? arowN[0] : arow[0]), (last ? arowN[1] : arow[1]), 0);
            PG_WAIT_V(8); PG_WAIT_L(0); PG_BAR; if (!Sched::HALVES || hf_ != 1) { PG_MMA(1, 0, At, B0); PG_MMA(1, 1, At, B1); } PG_BAR; PG_SCHED;
        }
        if constexpr (Sched::PREFETCH) {
            if (has_next) {
                const unsigned pf_lds = (unsigned)(size_t)lds + (unsigned)(LDS_PF_OFF) + (unsigned)wid * 256u;
                if constexpr (GATHER) { if ((wid & 1) == 0) { const unsigned q = (unsigned)lane & 3u; const unsigned ro = (q == 0 ? arowN[0] : q == 1 ? arowN[1] : q == 2 ? arowN[2] : arowN[3]) - colb; glds4_prefetch(uptr(nA + 128 * nxt.pn), ro, pf_lds); } }
                else { const unsigned t_ = (unsigned)tid & 255u, k_ = (unsigned)(2 * nxt.pn) + ((unsigned)tid >> 8); glds4_prefetch(uptr(nA), t_ * ROWB_ + 128u * k_, pf_lds); }
            }
        }
        if (wr == 0) PG_BAR;
        if constexpr (FP8) asm volatile("s_nop 15\n\ts_nop 15" ::: "memory");
        E(acc, cur, wr, wc, fr, fq, lds + LDS_EPI + (ui & 1) * 4096);
        if (!has_next) break;
        E.init(acc, nxt, wr, wc, fr, fq);
        cur = nxt; cA = nA; cB = nB; ++ui;
        if constexpr (GATHER) {
#pragma unroll
            for (int q = 0; q < 4; ++q) arow[q] = arowN[q];
        }
        if (wr == 1) PG_BAR;
    }
    PG_WAIT_V(0);
    PG_BAR;
#undef PG_SA
#undef PG_SB
#undef PG_STAGEA
#undef PG_STAGEB
#undef PG_LDA
#undef PG_LDB
#undef PG_MMA
#undef PG_WAIT_V
#undef PG_WAIT_L
#undef PG_BAR
#undef PG_SCHED
}

__device__ __forceinline__ void zero_acc(f32x4 (&acc)[2][2][4][2]) {
#pragma unroll
    for (int a = 0; a < 2; ++a)
#pragma unroll
        for (int b = 0; b < 2; ++b)
#pragma unroll
            for (int m = 0; m < 4; ++m)
#pragma unroll
                for (int n = 0; n < 2; ++n) acc[a][b][m][n] = (f32x4){0.f, 0.f, 0.f, 0.f};
}
template <unsigned RB = ROWB> __device__ __forceinline__ void dense_rows(int R0, unsigned colb, unsigned (&ar)[4]) {
#pragma unroll
    for (int q = 0; q < 4; ++q) ar[q] = (unsigned)(R0 + 64 * q) * RB + colb;
}
}

constexpr int NWAVES = 8;
constexpr int RING_BYTES = 131072;
constexpr int LDS_CTL_OFF = 139264;
constexpr int LDS_EPI_OFF = LDS_CTL_OFF + 8192;
constexpr int LDS_BYTES = 163840;

#define XB_TMO      128
#define XB_XCNT(j)  (256  + 64 * (j))
#define XB_XSUB(j)  (1280 + 64 * (j))
#define XB_XGEN(j)  (2304 + 64 * (j))
#define XB_TOP      3328
#define XB_TOPGEN   3392
#define XCD_BAR_WORDS 3456
#define XB_SPIN_CAP (1u << 18)
__device__ __forceinline__ unsigned xb_ld(unsigned* p)              { return __hip_atomic_load(p, __ATOMIC_RELAXED, __HIP_MEMORY_SCOPE_AGENT); }
__device__ __forceinline__ unsigned xb_add(unsigned* p, unsigned v) { return __hip_atomic_fetch_add(p, v, __ATOMIC_RELAXED, __HIP_MEMORY_SCOPE_AGENT); }
__device__ __forceinline__ unsigned xb_xcc_id() { return (unsigned)__builtin_amdgcn_s_getreg((3 << 11) | 20) & 0xFu; }
#define XB_SPIN(cond, bar) do { unsigned _sp = 0; while (cond) { __builtin_amdgcn_s_sleep(1); \
    if ((++_sp & 255u) == 0u) { if (xb_ld(&(bar)[XB_TMO])) break; if (_sp > XB_SPIN_CAP) { atomicAdd(&(bar)[XB_TMO], 1u); break; } } } } while (0)
struct XcdBarrier { unsigned* bar; unsigned x; volatile LAS unsigned* st; };
__device__ __forceinline__ XcdBarrier xcd_barrier_post(unsigned* bar, volatile LAS unsigned* st) {
    XcdBarrier b; b.bar = bar; b.x = xb_xcc_id(); b.st = st;
    if (threadIdx.x == 0) (void)xb_add(&bar[XB_XCNT(b.x)], 1u);
    return b;
}
__device__ __forceinline__ void xcd_barrier_complete(unsigned* bar, unsigned x, unsigned& nloc, unsigned& nx) {
    const unsigned G = gridDim.x * gridDim.y * gridDim.z;
    unsigned sum, cnt, mine, sp = 0u;
    for (;;) {
        sum = 0u; cnt = 0u; mine = 0u;
#pragma unroll
        for (unsigned j = 0; j < 16; ++j) { const unsigned c = xb_ld(&bar[XB_XCNT(j)]); sum += c; cnt += (c > 0u) ? 1u : 0u; mine = (j == x) ? c : mine; }
        if (sum == G) break;
        __builtin_amdgcn_s_sleep(1);
        if ((++sp & 255u) == 0u) { if (xb_ld(&bar[XB_TMO])) break; if (sp > XB_SPIN_CAP) { atomicAdd(&bar[XB_TMO], 1u); break; } }
    }
    nloc = mine > 0u ? mine : 1u; nx = cnt > 0u ? cnt : 1u;
}
__device__ __forceinline__ void xcd_barrier(const XcdBarrier& b) {
    asm volatile("s_waitcnt vmcnt(0)" ::: "memory");
    __syncthreads();
    if (threadIdx.x == 0) {
        unsigned* bar = b.bar;
        __builtin_amdgcn_s_waitcnt(0);
        unsigned nloc = b.st[0], nx = b.st[1];
        if (nloc == 0u) { xcd_barrier_complete(bar, b.x, nloc, nx); b.st[0] = nloc; b.st[1] = nx; }
        const unsigned old = xb_add(&bar[XB_XSUB(b.x)], 1u);
        const unsigned gen = old / nloc;
        if (old + 1u == (gen + 1u) * nloc) {
            __builtin_amdgcn_fence(__ATOMIC_RELEASE, "agent");
            asm volatile("s_waitcnt vmcnt(0)" ::: "memory");
            const unsigned og = xb_add(&bar[XB_TOP], 1u);
            const unsigned tg = og / nx;
            if (og + 1u == (tg + 1u) * nx) xb_add(&bar[XB_TOPGEN], 1u);
            else XB_SPIN(xb_ld(&bar[XB_TOPGEN]) == tg, bar);
            __builtin_amdgcn_fence(__ATOMIC_ACQUIRE, "agent");
            xb_add(&bar[XB_XGEN(b.x)], 1u);
            asm volatile("s_waitcnt vmcnt(0)" ::: "memory");
        } else {
            XB_SPIN(xb_ld(&bar[XB_XGEN(b.x)]) == gen, bar);
            __builtin_amdgcn_fence(__ATOMIC_ACQUIRE, "agent");
            asm volatile("s_waitcnt vmcnt(0)" ::: "memory");
        }
    }
    __syncthreads();
}

struct Frame {
    LAS unsigned char* lds;
    unsigned* ctl;
    unsigned char* ws;
    int tid, lane, wave, vcu, G, bx;
    const float* const* in;
    float* out;
    int flags;
};

__device__ __forceinline__ void p0_transpose_item(const float* __restrict__ src, int ld, int k0, int n0, f16* __restrict__ dst, int drow0, LAS unsigned* scr, int lane, const float* __restrict__ kscale = nullptr) {
    const int n4 = lane & 15, rr = lane >> 4;
    const float* s0 = src + (size_t)(k0 + 2 * rr) * ld + n0 + 4 * n4;
#pragma unroll 4
    for (int it = 0; it < 16; ++it) {
        float4 v0 = *(const float4*)(s0 + (size_t)(8 * it) * ld);
        float4 v1 = *(const float4*)(s0 + (size_t)(8 * it + 1) * ld);
        if (kscale) { const float g0 = kscale[k0 + 2 * rr + 8 * it], g1 = kscale[k0 + 2 * rr + 8 * it + 1]; v0.x *= g0; v0.y *= g0; v0.z *= g0; v0.w *= g0; v1.x *= g1; v1.y *= g1; v1.z *= g1; v1.w *= g1; }
        const int kp = it * 4 + rr;
        scr[(4 * n4 + 0) * 65 + kp] = pk_f16(v0.x, v1.x);
        scr[(4 * n4 + 1) * 65 + kp] = pk_f16(v0.y, v1.y);
        scr[(4 * n4 + 2) * 65 + kp] = pk_f16(v0.z, v1.z);
        scr[(4 * n4 + 3) * 65 + kp] = pk_f16(v0.w, v1.w);
    }
    asm volatile("s_waitcnt lgkmcnt(0)" ::: "memory");
    const int c = lane & 15, nl = lane >> 4;
#pragma unroll 4
    for (int jt = 0; jt < 16; ++jt) {
        const int n = jt * 4 + nl;
        u32x4 o; o.x = scr[n * 65 + 4 * c + 0]; o.y = scr[n * 65 + 4 * c + 1]; o.z = scr[n * 65 + 4 * c + 2]; o.w = scr[n * 65 + 4 * c + 3];
        *(u32x4*)(dst + (size_t)(drow0 + n) * 1024 + k0 + 8 * c) = o;
    }
    asm volatile("s_waitcnt lgkmcnt(0)" ::: "memory");
}
__device__ __forceinline__ void p0_transpose_item_fp8(const float* __restrict__ src, int ld, int k0, int n0, unsigned char* __restrict__ dst, int drow0, float sc, LAS unsigned* scr, int lane) {
    const int n4 = lane & 15, rr = lane >> 4;
    const float* s0 = src + (size_t)(k0 + 4 * rr) * ld + n0 + 4 * n4;
#pragma unroll 4
    for (int it = 0; it < 16; ++it) {
        const float* sp = s0 + (size_t)(16 * it) * ld;
        typedef float f4nt __attribute__((ext_vector_type(4)));
        const f4nt n0_ = __builtin_nontemporal_load((const f4nt*)(sp)), n1_ = __builtin_nontemporal_load((const f4nt*)(sp + ld)), n2_ = __builtin_nontemporal_load((const f4nt*)(sp + 2 * (size_t)ld)), n3_ = __builtin_nontemporal_load((const f4nt*)(sp + 3 * (size_t)ld));
        const float4 v0 = {n0_[0], n0_[1], n0_[2], n0_[3]}, v1 = {n1_[0], n1_[1], n1_[2], n1_[3]}, v2 = {n2_[0], n2_[1], n2_[2], n2_[3]}, v3 = {n3_[0], n3_[1], n3_[2], n3_[3]};
        const int kq = it * 4 + rr;
        scr[(4 * n4 + 0) * 65 + kq] = pk4_fp8(v0.x * sc, v1.x * sc, v2.x * sc, v3.x * sc);
        scr[(4 * n4 + 1) * 65 + kq] = pk4_fp8(v0.y * sc, v1.y * sc, v2.y * sc, v3.y * sc);
        scr[(4 * n4 + 2) * 65 + kq] = pk4_fp8(v0.z * sc, v1.z * sc, v2.z * sc, v3.z * sc);
        scr[(4 * n4 + 3) * 65 + kq] = pk4_fp8(v0.w * sc, v1.w * sc, v2.w * sc, v3.w * sc);
    }
    asm volatile("s_waitcnt lgkmcnt(0)" ::: "memory");
    const int c = lane & 15, nl = lane >> 4;
#pragma unroll 4
    for (int jt = 0; jt < 16; ++jt) {
        const int n = jt * 4 + nl;
        u32x4 o; o.x = scr[n * 65 + 4 * c + 0]; o.y = scr[n * 65 + 4 * c + 1]; o.z = scr[n * 65 + 4 * c + 2]; o.w = scr[n * 65 + 4 * c + 3];
        __builtin_nontemporal_store(o, (u32x4*)(dst + (size_t)(drow0 + n) * 1024 + k0 + 16 * c));
    }
    asm volatile("s_waitcnt lgkmcnt(0)" ::: "memory");
}
__device__ __forceinline__ void x_row_f16(const float* __restrict__ xrow, f16* __restrict__ orow, float* __restrict__ rstd_out, int lane) {
    const f32x4* xr = (const f32x4*)xrow + lane;
    f32x4 v[4]; float s = 0.f;
#pragma unroll
    for (int j = 0; j < 4; ++j) { v[j] = __builtin_nontemporal_load(xr + 64 * j); s += (v[j].x * v[j].x + v[j].y * v[j].y) + (v[j].z * v[j].z + v[j].w * v[j].w); }
    const float rstd = rsqrtf(wave_sum(s) * (1.f / D) + EPS);
    if (lane == 0) *rstd_out = rstd;
    u32x2* o8 = (u32x2*)orow + lane;
#pragma unroll
    for (int j = 0; j < 4; ++j) { u32x2 w; w.x = pk_f16(v[j].x, v[j].y); w.y = pk_f16(v[j].z, v[j].w); o8[64 * j] = w; }
}
__device__ __forceinline__ void rms_row_f16(const float* __restrict__ xrow, const float* __restrict__ g, f16* __restrict__ orow, int lane) {
    const f32x4* xr = (const f32x4*)xrow + lane;
    f32x4 v[4]; float s = 0.f;
#pragma unroll
    for (int j = 0; j < 4; ++j) { v[j] = __builtin_nontemporal_load(xr + 64 * j); s += (v[j].x * v[j].x + v[j].y * v[j].y) + (v[j].z * v[j].z + v[j].w * v[j].w); }
    const float rstd = rsqrtf(wave_sum(s) * (1.f / D) + EPS);
    u32x2* o8 = (u32x2*)orow + lane;
#pragma unroll
    for (int j = 0; j < 4; ++j) { const f32x4 gg = ((const f32x4*)g)[lane + 64 * j]; u32x2 w; w.x = pk_f16(v[j].x * rstd * gg.x, v[j].y * rstd * gg.y); w.y = pk_f16(v[j].z * rstd * gg.z, v[j].w * rstd * gg.w); o8[64 * j] = w; }
}
constexpr int P0_IGU = NE * 4 * (2 * DFF / 64), P0_IDN = NE * 4 * (D / 64), P0_IEXP = P0_IGU + P0_IDN;
constexpr int P1_NGEMM = 128;
constexpr int P1_IDLE0 = P1_NGEMM + 4;
constexpr int P1_ITEMS_PER_WAVE = 4;
constexpr int P0_DEFER = (256 - P1_IDLE0) * 8 * P1_ITEMS_PER_WAVE;
__device__ __forceinline__ void p0_expert_item(Frame& F, int r, LAS unsigned* scr) {
    const float* w_gu = F.in[19]; const float* w_down = F.in[21];
    unsigned char* WguT = F.ws + WS_WGUT; unsigned char* WdT = F.ws + WS_WDT;
    if (r < P0_IGU) { const int e = r / (4 * 32), q = r % (4 * 32), nb = q & 31, kb = q >> 5;
        p0_transpose_item_fp8(w_gu + (size_t)e * D * 2 * DFF, 2 * DFF, kb * 256, nb * 64, WguT + (size_t)e * 2 * DFF * 1024, gu_dest_row(nb * 64), SC_W, scr, F.lane); }
    else { r -= P0_IGU; const int e = r / (4 * 16), q = r % (4 * 16), nb = q & 15, kb = q >> 4; p0_transpose_item_fp8(w_down + (size_t)e * DFF * D, D, kb * 256, nb * 64, WdT + (size_t)e * D * 1024, nb * 64, SC_W, scr, F.lane); }
}
typedef float f4nt __attribute__((ext_vector_type(4)));
struct ExpItem { const float* s0; size_t ld; unsigned char* dst; };
__device__ __forceinline__ ExpItem exp_item(Frame& F, int r) {
    const float* w_gu = F.in[19]; const float* w_down = F.in[21];
    const int n4 = F.lane & 15, rr = F.lane >> 4;
    ExpItem I;
    if (r < P0_IGU) { const int e = r / (4 * 32), q = r % (4 * 32), nb = q & 31, kb = q >> 5;
        I.ld = 2 * DFF; I.s0 = w_gu + (size_t)e * D * 2 * DFF + (size_t)(kb * 256 + 4 * rr) * (2 * DFF) + nb * 64 + 4 * n4; I.dst = F.ws + WS_WGUT + (size_t)e * 2 * DFF * 1024 + (size_t)gu_dest_row(nb * 64) * 1024 + kb * 256; }
    else { r -= P0_IGU; const int e = r / (4 * 16), q = r % (4 * 16), nb = q & 15, kb = q >> 4;
        I.ld = D; I.s0 = w_down + (size_t)e * DFF * D + (size_t)(kb * 256 + 4 * rr) * D + nb * 64 + 4 * n4; I.dst = F.ws + WS_WDT + (size_t)e * D * 1024 + (size_t)(nb * 64) * 1024 + kb * 256; }
    return I;
}
__device__ __forceinline__ void exp_issue(const ExpItem& I, int b, f4nt (&buf)[16]) {
#pragma unroll
    for (int i = 0; i < 4; ++i) { const float* sp = I.s0 + (size_t)(16 * (4 * b + i)) * I.ld;
#pragma unroll
        for (int j = 0; j < 4; ++j) buf[4 * i + j] = __builtin_nontemporal_load((const f4nt*)(sp + j * I.ld)); }
}
__device__ __forceinline__ void exp_consume(const f4nt (&buf)[16], int b, LAS unsigned* scr, int lane) {
    const int n4 = lane & 15, rr = lane >> 4;
#pragma unroll
    for (int i = 0; i < 4; ++i) { const int kq = (4 * b + i) * 4 + rr;
#pragma unroll
        for (int c = 0; c < 4; ++c) scr[(4 * n4 + c) * 65 + kq] = pk4_fp8(buf[4 * i][c] * SC_W, buf[4 * i + 1][c] * SC_W, buf[4 * i + 2][c] * SC_W, buf[4 * i + 3][c] * SC_W); }
}
__device__ __forceinline__ void exp_flush(const ExpItem& I, LAS unsigned* scr, int lane) {
    asm volatile("s_waitcnt lgkmcnt(0)" ::: "memory");
    const int c = lane & 15, nl = lane >> 4;
#pragma unroll 4
    for (int jt = 0; jt < 16; ++jt) {
        const int n = jt * 4 + nl;
        u32x4 o; o.x = scr[n * 65 + 4 * c + 0]; o.y = scr[n * 65 + 4 * c + 1]; o.z = scr[n * 65 + 4 * c + 2]; o.w = scr[n * 65 + 4 * c + 3];
        __builtin_nontemporal_store(o, (u32x4*)(I.dst + (size_t)n * 1024 + 16 * c));
    }
    asm volatile("s_waitcnt lgkmcnt(0)" ::: "memory");
}
__device__ __forceinline__ void p0_expert_run(Frame& F, int base, int start, int stride, int end, LAS unsigned* scr) {
    int it = start;
    if (it >= end) return;
    ExpItem cur = exp_item(F, base + it), nxt = cur;
    f4nt A[16], B[16];
    exp_issue(cur, 0, A);
    for (;;) {
        const int itn = it + stride; const bool has = itn < end;
        if (has) nxt = exp_item(F, base + itn);
        exp_issue(cur, 1, B); exp_consume(A, 0, scr, F.lane);
        exp_issue(cur, 2, A); exp_consume(B, 1, scr, F.lane);
        exp_issue(cur, 3, B); exp_consume(A, 2, scr, F.lane);
        if (has) exp_issue(nxt, 0, A);
        exp_consume(B, 3, scr, F.lane);
        exp_flush(cur, scr, F.lane);
        if (!has) break;
        cur = nxt; it = itn;
    }
}
__device__ __forceinline__ void p1_deferred_items(Frame& F) {
    if (F.G != 256 || F.bx < P1_IDLE0) { if (F.G != 256) { LAS unsigned* scr = (LAS unsigned*)(F.lds + F.wave * 16896); p0_expert_run(F, P0_IEXP - P0_DEFER, F.vcu * NWAVES + F.wave, F.G * NWAVES, P0_DEFER, scr); } return; }
    LAS unsigned* scr = (LAS unsigned*)(F.lds + F.wave * 16896);
    p0_expert_run(F, P0_IEXP - P0_DEFER, (F.bx - P1_IDLE0) * NWAVES + F.wave, (256 - P1_IDLE0) * NWAVES, P0_DEFER, scr);
}
__device__ __forceinline__ void p0_prologue(Frame& F) {
    LAS unsigned* scr = (LAS unsigned*)(F.lds + F.wave * 16896);
    const int gw = F.vcu * NWAVES + F.wave, NGW = F.G * NWAVES;
    const float* w_in = F.in[3]; const float* w_kv = F.in[14]; const float* w_out = F.in[15];
    f16* WinT = (f16*)(F.ws + WS_WINT); f16* WoutT = (f16*)(F.ws + WS_WOUTT); f16* WkvT = (f16*)(F.ws + WS_WKVT);
    constexpr int I_IN = 8 * (DIN / 64), I_OUT = 8 * (D / 64), I_KV = 8 * (2 * DX / 64);
    constexpr int NITEMS = I_IN + I_OUT + I_KV + (P0_IEXP - P0_DEFER);
    p0_expert_run(F, 0, gw, NGW, P0_IEXP - P0_DEFER, scr);
    for (int it = (P0_IEXP - P0_DEFER) / NGW * NGW + gw; it < NITEMS; it += NGW) {
        int r = it;
        if (r < P0_IEXP - P0_DEFER) continue;
        r -= (P0_IEXP - P0_DEFER);
        if (r < I_IN) { const int nb = r >> 3, kb = r & 7; p0_transpose_item(w_in, DIN, kb * 128, nb * 64, WinT, nb * 64, scr, F.lane, F.in[2]); continue; }
        r -= I_IN;
        if (r < I_OUT) { const int nb = r >> 3, kb = r & 7; p0_transpose_item(w_out, D, kb * 128, nb * 64, WoutT, nb * 64, scr, F.lane); continue; } r -= I_OUT;
        { const int nb = r >> 3, kb = r & 7; p0_transpose_item(w_kv, 2 * DX, kb * 128, nb * 64, WkvT, nb * 64, scr, F.lane); }
    }
    f16* H0 = (f16*)(F.ws + WS_H0); f16* MEMN = (f16*)(F.ws + WS_MEMN);
    for (int m = gw; m < T + BATCH * NMEM; m += NGW) {
        if (m < T) x_row_f16(F.in[0] + (size_t)m * D, H0 + (size_t)m * D, (float*)(F.ws + WS_RSTD0) + m, F.lane);
        else rms_row_f16(F.in[1] + (size_t)(m - T) * D, F.in[13], MEMN + (size_t)(m - T) * D, F.lane);
    }
    { unsigned long long* agz = (unsigned long long*)(F.ws + WS_AGG) + (size_t)F.bx * DRNN; if (F.bx < T / 64) agz[F.tid] = 0ull; if (F.bx < 16) agz[(size_t)256 * DRNN + F.tid] = 0ull; }
    if (gw == 0) { u32x4* z = (u32x4*)(F.ws + WS_X1N + (size_t)T * D); z[F.lane] = (u32x4){0u, 0u, 0u, 0u}; if (F.lane == 0) ((float*)(F.ws + WS_TOPG))[TK] = 0.f; }
}

struct SchedP1 {
    static constexpr bool GATHER = false, PREFETCH = false, HALVES = false;
    const char* H0; const char* WinT; const char* MEMN; const char* WkvT; int G, c;
    __device__ __forceinline__ bool next(int i, pg::Unit& u) const {
        constexpr int NP = 64 * 6;
        int L;
        if (G == 256) {
            if (c < P1_NGEMM) { L = i * P1_NGEMM + c; if (L >= NP) return false; }
            else { if (i > 0 || c >= P1_NGEMM + 4) return false; L = NP + (c - P1_NGEMM); }
        } else { L = i * G + c; if (L >= NP + 4) return false; }
        if (L < NP) {
            int wgid = L; { const int q = NP / 8, xcd = wgid % 8, off = wgid / 8; wgid = xcd * q + off; }
            const int nig = 8 * 6, gid = wgid / nig, fm = gid * 8;
            u.pm = fm + ((wgid % nig) % 8); u.pn = (wgid % nig) / 8; u.kind = 0;
            u.A = H0 + (size_t)u.pm * 256 * pg::ROWB; u.B = WinT + (size_t)u.pn * 256 * pg::ROWB;
                    u.e = 0; u.hrow = u.pm * 256; u.p0 = u.pn * 256; u.cnt = DIN;
        } else {
            const int q = L - NP, b = q >> 1, v = q & 1; u.pm = b; u.pn = v; u.kind = 1; u.e = 1 + q; u.hrow = 0; u.p0 = 0; u.cnt = DX;
            const char* mb = MEMN + (size_t)b * 256 * pg::ROWB; const char* wv = WkvT + (size_t)v * 256 * pg::ROWB;
            u.A = v ? wv : mb; u.B = v ? mb : wv; }
        return true;
    }
    __device__ __forceinline__ void rows(const pg::Unit&, int R0, unsigned colb, unsigned (&ar)[4]) const { pg::dense_rows(R0, colb, ar); }
};
struct EpiP1 {
    static constexpr bool PERM = true, FP8 = false;
    f16* proj; f16* Kh; f16* VT; const float* rstd0;
    __device__ __forceinline__ void init(f32x4 (&acc)[2][2][4][2], const pg::Unit&, int, int, int, int) const { pg::zero_acc(acc); }
    __device__ __forceinline__ void prefetch(const pg::Unit&, int, int, unsigned) const {}
    __device__ __forceinline__ void operator()(const f32x4 (&acc)[2][2][4][2], const pg::Unit& u, int wr, int wc, int fr, int fq, const LAS unsigned char*) const {
        f16* base = proj;
        if (u.e != 0) { const int q = u.e - 1; base = ((q & 1) ? VT : Kh) + (size_t)(q >> 1) * NMEM * DX; }
        const int ld = u.cnt;
        const int row0 = u.hrow + wr * 64 + fr, col0 = u.p0 + wc * 32 + 8 * fq;
#pragma unroll
        for (int ai = 0; ai < 2; ++ai)
#pragma unroll
            for (int m = 0; m < 4; ++m) { f16* rowp = base + (size_t)(row0 + ai * 128 + m * 16) * ld + col0;
                const float rsc = (u.e == 0) ? rstd0[row0 + ai * 128 + m * 16] : 1.f;
#pragma unroll
                for (int bj = 0; bj < 2; ++bj) { const f32x4 v0 = acc[ai][bj][m][0] * rsc, v1 = acc[ai][bj][m][1] * rsc;
                    u32x4 w; w.x = pk_f16(v0[0], v0[1]); w.y = pk_f16(v0[2], v0[3]); w.z = pk_f16(v1[0], v1[1]); w.w = pk_f16(v1[2], v1[3]);
                    *(u32x4*)(rowp + bj * 128) = w; } }
    }
};

struct SchedP3 {
    static constexpr bool GATHER = false, PREFETCH = false, HALVES = false;
    const char* MIX; const char* WoutT; int L;
    __device__ __forceinline__ bool next(int i, pg::Unit& u) const {
        constexpr int NP = 64 * 4;
        if (i > 0 || L >= NP) return false;
        int wgid = L; { const int q = NP / 8, xcd = wgid % 8, off = wgid / 8; wgid = xcd * q + off; }
        const int nig = 8 * 4, gid = wgid / nig, fm = gid * 8;
        u.pm = fm + ((wgid % nig) % 8); u.pn = (wgid % nig) / 8; u.kind = 0;
        u.A = MIX + (size_t)u.pm * 256 * pg::ROWB; u.B = WoutT + (size_t)u.pn * 256 * pg::ROWB;
        u.e = 0; u.p0 = 0; u.cnt = 0; u.hrow = 0;
        return true;
    }
    __device__ __forceinline__ void rows(const pg::Unit&, int R0, unsigned colb, unsigned (&ar)[4]) const { pg::dense_rows(R0, colb, ar); }
};
struct EpiP3 {
    static constexpr bool PERM = true, FP8 = false;
    const f16* x; f16* x1; unsigned char* x1g8; const float* gffn; const f16* WrH; float* PARTL; float* SSQP; LAS unsigned char* lds;
    __device__ __forceinline__ void init(f32x4 (&acc)[2][2][4][2], const pg::Unit& u, int wr, int wc, int fr, int fq) const {
        const f16* xp = x + (size_t)(u.pm * 256 + wr * 64 + fr) * D + u.pn * 256 + wc * 32 + 8 * fq;
        f16x8 hv[2][4][2];
#pragma unroll
        for (int ai = 0; ai < 2; ++ai)
#pragma unroll
            for (int m = 0; m < 4; ++m)
#pragma unroll
                for (int bj = 0; bj < 2; ++bj) hv[ai][m][bj] = __builtin_nontemporal_load((const f16x8*)(xp + (size_t)(ai * 128 + m * 16) * D + bj * 128));
#pragma unroll
        for (int ai = 0; ai < 2; ++ai)
#pragma unroll
            for (int m = 0; m < 4; ++m)
#pragma unroll
                for (int bj = 0; bj < 2; ++bj) { const f16x8 h = hv[ai][m][bj];
                    acc[ai][bj][m][0] = (f32x4){(float)h[0], (float)h[1], (float)h[2], (float)h[3]}; acc[ai][bj][m][1] = (f32x4){(float)h[4], (float)h[5], (float)h[6], (float)h[7]}; }
    }
    __device__ __forceinline__ void prefetch(const pg::Unit&, int, int, unsigned) const {}
    __device__ __forceinline__ void operator()(const f32x4 (&acc)[2][2][4][2], const pg::Unit& u, int wr, int wc, int fr, int fq, const LAS unsigned char*) const {
        const int wave = wr * 4 + wc;
        const int row0 = u.pm * 256 + wr * 64 + fr, col0 = u.pn * 256 + wc * 32 + 8 * fq;
        f16x8 wrh[2][2], wrl[2][2];
        f32x4 gg[2][2];
#pragma unroll
        for (int bj = 0; bj < 2; ++bj) {
#pragma unroll
            for (int eh = 0; eh < 2; ++eh) { const size_t o = (size_t)(16 * eh + fr) * D + col0 + 128 * bj; wrh[bj][eh] = *(const f16x8*)(WrH + o); wrl[bj][eh] = *(const f16x8*)(WrH + (size_t)NE * D + o); }
            gg[bj][0] = *(const f32x4*)(gffn + col0 + 128 * bj) * SC_X; gg[bj][1] = *(const f32x4*)(gffn + col0 + 128 * bj + 4) * SC_X;
        }
        asm volatile("s_waitcnt vmcnt(0)" ::: "memory");
        __builtin_amdgcn_s_barrier();
        LAS float* PL = (LAS float*)lds + wave * (128 * 32);
        LAS float* SS = (LAS float*)(lds + LDS_EPI_OFF) + wave * 128;
#pragma unroll
        for (int ai = 0; ai < 2; ++ai)
#pragma unroll
            for (int p = 0; p < 2; ++p) {
                u32x2 wv[2][2];
#pragma unroll
                for (int mm = 0; mm < 2; ++mm) {
                    const int m = 2 * p + mm;
                    const size_t off = (size_t)(row0 + ai * 128 + m * 16) * D + col0;
                    f32x4 L0 = {0.f, 0.f, 0.f, 0.f}, L1 = {0.f, 0.f, 0.f, 0.f}; float ss = 0.f;
#pragma unroll
                    for (int bj = 0; bj < 2; ++bj) {
                        const f32x4 v0 = acc[ai][bj][m][0], v1 = acc[ai][bj][m][1];
                        u32x4 w; w.x = pk_f16(v0[0], v0[1]); w.y = pk_f16(v0[2], v0[3]); w.z = pk_f16(v1[0], v1[1]); w.w = pk_f16(v1[2], v1[3]);
                        *(u32x4*)(x1 + off + bj * 128) = w;
                        const f16x8 hv = __builtin_bit_cast(f16x8, w);
                        const f32x4 h0 = {(float)hv[0], (float)hv[1], (float)hv[2], (float)hv[3]}, h1 = {(float)hv[4], (float)hv[5], (float)hv[6], (float)hv[7]};
                        ss += ((h0[0] * h0[0] + h0[1] * h0[1]) + (h0[2] * h0[2] + h0[3] * h0[3])) + ((h1[0] * h1[0] + h1[1] * h1[1]) + (h1[2] * h1[2] + h1[3] * h1[3]));
                        const f32x4 q0 = h0 * gg[bj][0], q1 = h1 * gg[bj][1];
                        wv[mm][bj].x = pk4_fp8(q0[0], q0[1], q0[2], q0[3]); wv[mm][bj].y = pk4_fp8(q1[0], q1[1], q1[2], q1[3]);
                        L0 = __builtin_amdgcn_mfma_f32_16x16x32_f16(wrh[bj][0], hv, L0, 0, 0, 0); L1 = __builtin_amdgcn_mfma_f32_16x16x32_f16(wrh[bj][1], hv, L1, 0, 0, 0);
                        L0 = __builtin_amdgcn_mfma_f32_16x16x32_f16(wrl[bj][0], hv, L0, 0, 0, 0); L1 = __builtin_amdgcn_mfma_f32_16x16x32_f16(wrl[bj][1], hv, L1, 0, 0, 0);
                    }
                    const int rl = (ai * 4 + m) * 16 + fr;
                    *(LAS f32x4*)(PL + rl * 32 + 4 * fq) = L0; *(LAS f32x4*)(PL + rl * 32 + 16 + 4 * fq) = L1;
                    ss += __shfl_xor(ss, 16); ss += __shfl_xor(ss, 32);
                    if (fq == 0) SS[rl] = ss;
                }
#pragma unroll
                for (int bj = 0; bj < 2; ++bj) {
                    const auto rx = __builtin_amdgcn_permlane16_swap(wv[0][bj].x, wv[1][bj].x, false, false);
                    const auto ry = __builtin_amdgcn_permlane16_swap(wv[0][bj].y, wv[1][bj].y, false, false);
                    const int r = row0 + ai * 128 + (2 * p + (fq & 1)) * 16;
                    u32x4 w16; w16.x = rx[0]; w16.y = ry[0]; w16.z = rx[1]; w16.w = ry[1];
                    *(u32x4*)(x1g8 + (size_t)r * D + u.pn * 256 + wc * 32 + 16 * (fq >> 1) + bj * 128) = w16;
                }
            }
        asm volatile("s_waitcnt lgkmcnt(0)" ::: "memory");
        __builtin_amdgcn_s_barrier();
        {
            const int t = (int)threadIdx.x, r256 = t >> 1, eh = t & 1;
            const int ai_ = r256 >> 7, wr_ = (r256 >> 6) & 1, rl = (ai_ * 4 + ((r256 >> 4) & 3)) * 16 + (r256 & 15);
            const LAS float* pl = (const LAS float*)lds + (wr_ * 4) * (128 * 32) + rl * 32 + 16 * eh;
            const size_t grow = (size_t)u.pn * T + (size_t)u.pm * 256 + r256;
#pragma unroll
            for (int q = 0; q < 4; ++q) {
                f32x4 sum = *(const LAS f32x4*)(pl + 4 * q);
#pragma unroll
                for (int c = 1; c < 4; ++c) sum += *(const LAS f32x4*)(pl + c * (128 * 32) + 4 * q);
                *(f32x4*)(PARTL + grow * 32 + 16 * eh + 4 * q) = sum;
            }
            if (eh == 0) { const LAS float* sp = (const LAS float*)(lds + LDS_EPI_OFF) + (wr_ * 4) * 128 + rl; SSQP[grow] = ((sp[0] + sp[128]) + sp[256]) + sp[384]; }
        }
    }
};

template <int NCT, bool GATHER_> struct SchedMoe {
    static constexpr bool GATHER = GATHER_, PREFETCH = true, HALVES = true;
    const char* Abase; const char* Wbase; size_t wstride_e; const int* list; const LAS int* tab; int G, c;
    __device__ __forceinline__ bool next(int i, pg::Unit& u) const {
        const int ntiles = __builtin_amdgcn_readfirstlane(tab[NE]);
        const int per = G >> 3;
        const int U = ntiles * NCT, Uc = (U + 7) / 8, x = c & 7, j = c >> 3;
        int Ux = U - x * Uc; Ux = Ux < 0 ? 0 : (Ux > Uc ? Uc : Ux);
        const int nfull = Ux / per, rem = Ux - nfull * per;
        int Lx, half = 0;
        if (i < nfull) Lx = j + per * i;
        else if (i == nfull && rem > 0) {
            if (2 * rem <= per) { if (j >= 2 * rem) return false; Lx = nfull * per + (j >> 1); half = 1 + (j & 1); }
            else { if (j >= rem) return false; Lx = nfull * per + j; }
        } else return false;
        const int L = x * Uc + Lx;
        const int RT = L / NCT, ct = L % NCT;
        const int ln = (int)(threadIdx.x & 63u);
        const unsigned long long mm = __ballot((ln < NE) && (tab[ln & 31] <= RT));
        const int e = 63 - __builtin_clzll(mm);
        const int t0 = __builtin_amdgcn_readfirstlane(tab[e]);
        u.e = e; u.p0 = (RT - t0) * 256; u.cnt = __builtin_amdgcn_readfirstlane(tab[40 + e]); u.hrow = RT * 256; u.pn = ct; u.pm = RT;
        if (half == 0 && u.cnt - u.p0 <= 128) half = 1;
        u.kind = half;
        u.B = Wbase + (size_t)e * wstride_e + (size_t)ct * 256 * pg::ROWB8;
        u.A = GATHER_ ? Abase : Abase + (size_t)u.hrow * pg::ROWB8;
        return true;
    }
    __device__ __forceinline__ void rows_issue(const pg::Unit& u, int R0, unsigned (&raw)[4]) const {
        const int idx = __builtin_amdgcn_readfirstlane(u.e * T + u.p0);
        const char* lb = (const char*)(list + idx);
        const unsigned off = (unsigned)R0 * 4u;
        asm volatile("global_load_dword %0, %4, %5\n\tglobal_load_dword %1, %4, %5 offset:256\n\tglobal_load_dword %2, %4, %5 offset:512\n\tglobal_load_dword %3, %4, %5 offset:768"
                     : "=&v"(raw[0]), "=&v"(raw[1]), "=&v"(raw[2]), "=&v"(raw[3]) : "v"(off), "s"(lb) : "memory");
    }
    __device__ __forceinline__ void rows_finish(const pg::Unit& u, int R0, unsigned colb, const unsigned (&raw)[4], unsigned (&ar)[4]) const {
#pragma unroll
        for (int q = 0; q < 4; ++q) { const int pos = u.p0 + R0 + 64 * q; const unsigned tok = (pos < u.cnt) ? (raw[q] >> 2) : (unsigned)T; ar[q] = tok * pg::ROWB8 + colb; }
    }
    __device__ __forceinline__ void rows(const pg::Unit& u, int R0, unsigned colb, unsigned (&ar)[4]) const {
        if (GATHER_) {
#pragma unroll
            for (int q = 0; q < 4; ++q) { const int pos = u.p0 + R0 + 64 * q; const int posc = pos < u.cnt ? pos : u.cnt - 1; const int le = list[u.e * T + posc]; const int tok = pos < u.cnt ? (le >> 2) : T; ar[q] = (unsigned)tok * pg::ROWB8 + colb; }
        } else pg::dense_rows<pg::ROWB8>(R0, colb, ar);
    }
};
struct EpiGU {
    static constexpr bool PERM = true, FP8 = true;
    const float* b_gu; const float* rlist; unsigned char* Hbuf; int skip;
    __device__ __forceinline__ void init(f32x4 (&acc)[2][2][4][2], const pg::Unit&, int, int, int, int) const { pg::zero_acc(acc); }
    __device__ __forceinline__ void prefetch(const pg::Unit& u, int wid, int lane, unsigned slot) const {
        if (wid == 0) { const unsigned voff = (unsigned)((lane < 32 ? (u.pn * 128 + 4 * lane) : (DFF + u.pn * 128 + 4 * (lane - 32))) * 4); pg::glds16n(pg::uptr((const char*)(b_gu + (size_t)u.e * 2 * DFF)), voff, slot);
            pg::glds16n(pg::uptr((const char*)(rlist + (size_t)u.e * T + u.p0)), (unsigned)lane * 16u, slot + 1024u); }
    }
    __device__ __forceinline__ void operator()(const f32x4 (&acc)[2][2][4][2], const pg::Unit& u, int wr, int wc, int fr, int fq, const LAS unsigned char* slot) const {
        if (skip) return;
        const int cj = u.pn * 128 + wc * 32 + 8 * fq;
        f32x4 bgv[2], buv[2];
#pragma unroll
        for (int n = 0; n < 2; ++n) { bgv[n] = *(const LAS f32x4*)(slot + (wc * 32 + 8 * fq + 4 * n) * 4); buv[n] = *(const LAS f32x4*)(slot + 512 + (wc * 32 + 8 * fq + 4 * n) * 4); }
        const int cj16 = u.pn * 128 + wc * 32 + 16 * (fq >> 1);
#pragma unroll
        for (int ai = 0; ai < 2; ++ai) {
            if (u.kind == 2 - ai) continue;
            u32x2 wv[4];
#pragma unroll
            for (int m = 0; m < 4; ++m) {
                float o[8];
                const int rl = ai * 128 + wr * 64 + m * 16 + fr;
                const float rsc = ((u.p0 + rl) < u.cnt ? ((const LAS float*)(slot + 1024))[rl] : 0.f) * (1.f / (SC_W * SC_X));
#pragma unroll
                for (int n = 0; n < 2; ++n)
#pragma unroll
                    for (int j = 0; j < 4; j += 2) {
                        constexpr float c1 = -1.702f * 1.4426950408889634f, kk = SC_H / c1;
                        const f32x2 ag = {acc[ai][0][m][n][j], acc[ai][0][m][n][j + 1]}, au_ = {acc[ai][1][m][n][j], acc[ai][1][m][n][j + 1]};
                        const f32x2 bg2 = {bgv[n][j], bgv[n][j + 1]}, bu2 = {buv[n][j], buv[n][j + 1]};
                        f32x2 t = ag * (rsc * c1) + bg2 * c1, uv = au_ * rsc + bu2;
                        t[0] = fmaxf(t[0], 7.f * c1); t[1] = fmaxf(t[1], 7.f * c1);
                        uv[0] = __builtin_amdgcn_fmed3f(uv[0], -7.f, 7.f); uv[1] = __builtin_amdgcn_fmed3f(uv[1], -7.f, 7.f);
                        f32x2 e2 = {__builtin_amdgcn_exp2f(t[0]), __builtin_amdgcn_exp2f(t[1])};
                        e2 = e2 + 1.f;
                        const f32x2 sg = {__builtin_amdgcn_rcpf(e2[0]), __builtin_amdgcn_rcpf(e2[1])};
                        const f32x2 ov = (uv * kk + kk) * (t * sg);
                        o[4 * n + j] = ov[0]; o[4 * n + j + 1] = ov[1];
                    }
                wv[m].x = pk4_fp8(o[0], o[1], o[2], o[3]); wv[m].y = pk4_fp8(o[4], o[5], o[6], o[7]);
            }
#pragma unroll
            for (int p = 0; p < 2; ++p) {
                const auto rx = __builtin_amdgcn_permlane16_swap(wv[2 * p].x, wv[2 * p + 1].x, false, false);
                const auto ry = __builtin_amdgcn_permlane16_swap(wv[2 * p].y, wv[2 * p + 1].y, false, false);
                const int r = ai * 128 + wr * 64 + (2 * p + (fq & 1)) * 16 + fr;
                u32x4 w16; w16.x = rx[0]; w16.y = ry[0]; w16.z = rx[1]; w16.w = ry[1];
                *(u32x4*)(Hbuf + (size_t)(u.hrow + r) * DFF + cj16) = w16;
            }
        }
    }
};
struct EpiDown {
    static constexpr bool PERM = true, FP8 = true;
    const float* b_down; const int* list; const float* glist; unsigned char* Y; int skip;
    __device__ __forceinline__ void init(f32x4 (&acc)[2][2][4][2], const pg::Unit&, int, int, int, int) const { pg::zero_acc(acc); }
    __device__ __forceinline__ void prefetch(const pg::Unit& u, int wid, int lane, unsigned slot) const {
        if (wid == 0) { const unsigned voff = (unsigned)lane * 16u;
            pg::glds16n(pg::uptr((const char*)(b_down + (size_t)u.e * D + u.pn * 256)), voff, slot);
            pg::glds16n(pg::uptr((const char*)(list + (size_t)u.e * T + u.p0)), voff, slot + 1024u);
            pg::glds16n(pg::uptr((const char*)(glist + (size_t)u.e * T + u.p0)), voff, slot + 2048u); }
    }
    __device__ __forceinline__ void operator()(const f32x4 (&acc)[2][2][4][2], const pg::Unit& u, int wr, int wc, int fr, int fq, const LAS unsigned char* slotp) const {
        if (skip) return;
        const int c0 = u.pn * 256 + wc * 32 + 8 * fq;
        f32x4 bv[2][2];
#pragma unroll
        for (int bj = 0; bj < 2; ++bj)
#pragma unroll
            for (int n = 0; n < 2; ++n) bv[bj][n] = *(const LAS f32x4*)(slotp + (bj * 128 + wc * 32 + 8 * fq + 4 * n) * 4);
        const int c16 = u.pn * 256 + wc * 32 + 16 * (fq >> 1);
#pragma unroll
        for (int ai = 0; ai < 2; ++ai) {
            if (u.kind == 2 - ai) continue;
#pragma unroll
            for (int p = 0; p < 2; ++p) {
                const int rA = ai * 128 + wr * 64 + (2 * p) * 16 + fr, rB = rA + 16;
                const int slA = ((const LAS int*)(slotp + 1024))[rA], slB = ((const LAS int*)(slotp + 1024))[rB];
                const float glA = ((const LAS float*)(slotp + 2048))[rA], glB = ((const LAS float*)(slotp + 2048))[rB];
                const bool okA = (u.p0 + rA) < u.cnt, okB = (u.p0 + rB) < u.cnt;
                const int slotA = okA ? slA : TK, slotB = okB ? slB : TK;
                const float gtA = (okA ? glA : 0.f) * SC_Y, gtB = (okB ? glB : 0.f) * SC_Y;
                const int slot = (fq & 1) ? slotB : slotA;
                unsigned char* rowp = Y + (size_t)slot * D + c16;
#pragma unroll
                for (int bj = 0; bj < 2; ++bj) {
                    const f32x4 a0 = (acc[ai][bj][2 * p][0] * (1.f / (SC_W * SC_H)) + bv[bj][0]) * gtA, a1 = (acc[ai][bj][2 * p][1] * (1.f / (SC_W * SC_H)) + bv[bj][1]) * gtA;
                    const f32x4 b0 = (acc[ai][bj][2 * p + 1][0] * (1.f / (SC_W * SC_H)) + bv[bj][0]) * gtB, b1 = (acc[ai][bj][2 * p + 1][1] * (1.f / (SC_W * SC_H)) + bv[bj][1]) * gtB;
                    const unsigned ax = pk4_fp8(a0[0], a0[1], a0[2], a0[3]), ay = pk4_fp8(a1[0], a1[1], a1[2], a1[3]);
                    const unsigned bx = pk4_fp8(b0[0], b0[1], b0[2], b0[3]), by = pk4_fp8(b1[0], b1[1], b1[2], b1[3]);
                    const auto rx = __builtin_amdgcn_permlane16_swap(ax, bx, false, false);
                    const auto ry = __builtin_amdgcn_permlane16_swap(ay, by, false, false);
                    u32x4 w16; w16.x = rx[0]; w16.y = ry[0]; w16.z = rx[1]; w16.w = ry[1];
                    *(u32x4*)(rowp + bj * 128) = w16;
                }
            }
        }
    }
};
__device__ __forceinline__ void moe_table(Frame& F) {
    LAS int* tab = (LAS int*)(F.lds + LDS_CTL_OFF + 256);
    if (F.tid == 0) { int tt = 0; for (int e = 0; e < NE; ++e) { const int c = (int)F.ctl[CW_COUNTS + 64 * e]; tab[e] = tt; tab[40 + e] = c; tt += (c + 255) >> 8; } tab[NE] = tt; }
    __syncthreads();
}

constexpr size_t SW_WAT = 0, SW_WIT = 64 * 1024, SW_WPT = 128 * 1024, SW_WRP = 256 * 1024;
__device__ __forceinline__ void p0_small(Frame& F) {
    const int gt = F.vcu * (NWAVES * 64) + F.tid, NTH = F.G * NWAVES * 64;
    f16* WaT = (f16*)(F.ws + WS_SMALLW + SW_WAT); f16* WiT = (f16*)(F.ws + WS_SMALLW + SW_WIT); f16* WpT = (f16*)(F.ws + WS_SMALLW + SW_WPT); f16* WrH = (f16*)(F.ws + WS_SMALLW + SW_WRP); f16* WrL = WrH + NE * D;
    const float* w_a = F.in[6]; const float* w_i = F.in[8]; const float* w_p = F.in[11]; const float* gffn = F.in[16]; const float* w_r = F.in[17];
    for (int idx = gt; idx < NH * 64 * 64; idx += NTH) { const int h = idx >> 12, j = (idx >> 6) & 63, i = idx & 63; WaT[idx] = (f16)w_a[(h * 64 + i) * 64 + j]; WiT[idx] = (f16)w_i[(h * 64 + i) * 64 + j]; }
    for (int idx = gt; idx < 4 * 64 * 64; idx += NTH) { const int g = idx >> 12, j = (idx >> 6) & 63, i = idx & 63; WpT[idx] = (f16)w_p[(g * 64 + i) * 64 + j]; }
    for (int idx = gt; idx < D * NE; idx += NTH) { const int k = idx >> 5, e = idx & 31; const float wv = 1024.f * (gffn[k] * w_r[idx]); const f16 hh = (f16)wv; WrH[e * D + k] = hh; WrL[e * D + k] = (f16)(wv - (float)hh); }
}

typedef float f32x16 __attribute__((ext_vector_type(16)));
constexpr int UCS_PITCH = 520;
constexpr int DT_PITCH = 264;
constexpr int P2_DT_OFF = 64 * UCS_PITCH * 2;
constexpr int P2_STG_OFF = P2_DT_OFF + 64 * DT_PITCH * 2;
constexpr float LOG2E = 1.4426950408889634f;
__device__ __forceinline__ float sigmoid_fast(float x) { return __builtin_amdgcn_rcpf(1.f + __builtin_amdgcn_exp2f(-x * LOG2E)); }
__device__ __forceinline__ float gelu_tanh_fast(float x) {
    const float u2 = 1.5957691216057308f * (x + 0.044715f * x * x * x);
    return x * sigmoid_fast(u2);
}
template <int W> __device__ __forceinline__ void pool_d2(const unsigned* up2, int tpos0, LAS unsigned* dst) {
    f32x2 u[16 + W - 1];
#pragma unroll
    for (int i = 0; i < 16 + W - 1; ++i) {
        const int rel = i - (W - 1), lim = -tpos0, rc = rel < lim ? lim : rel;
        const unsigned ld = up2[(ptrdiff_t)rc * (DIN / 2)];
        const unsigned raw = (rel >= lim) ? ld : 0u;
        const f16x2 h = __builtin_bit_cast(f16x2, raw);
        u[i] = (f32x2){(float)h[0], (float)h[1]};
    }
#pragma unroll
    for (int t = 0; t < 16; ++t) {
        f32x2 sacc = {0.f, 0.f};
#pragma unroll
        for (int q = 0; q < W; ++q) sacc += u[t + (W - 1) - q];
        const int n = (tpos0 + t + 1 < W) ? (tpos0 + t + 1) : W;
        const float rn = 1.f / (float)n;
        const f32x2 d = sacc * rn - u[t + W - 1];
        dst[t * (DT_PITCH / 2)] = pk_f16(d[0], d[1]);
    }
}
__device__ __forceinline__ void lookback16(const unsigned long long* base, int n, float& la, float& lh) {
    unsigned long long g[16];
    for (unsigned spin = 0;; ++spin) {
        bool ok = true;
#pragma unroll
        for (int i = 0; i < 16; ++i) { const int k = i < n ? i : (n > 0 ? n - 1 : 0);
            g[i] = __hip_atomic_load((unsigned long long*)base + (size_t)k * DRNN, __ATOMIC_RELAXED, __HIP_MEMORY_SCOPE_AGENT);
            if (i < n) ok = ok && ((unsigned)g[i] != 0u); }
        if (ok || spin > (1u << 18)) break;
        __builtin_amdgcn_s_sleep(2);
    }
    la = 1.f; lh = 0.f;
#pragma unroll
    for (int i = 0; i < 16; ++i) if (i < n) { const float a = __uint_as_float((unsigned)g[i]), hh = __uint_as_float((unsigned)(g[i] >> 32)); lh = a * lh + hh; la = a * la; }
}
__device__ __forceinline__ void p2_mixer(Frame& F) {
    const f16* proj = (const f16*)(F.ws + WS_PROJ);
    f16* mixed = (f16*)(F.ws + WS_MIXED);
    unsigned long long* AGG = (unsigned long long*)(F.ws + WS_AGG);
    const f16* WaT = (const f16*)(F.ws + WS_SMALLW + SW_WAT); const f16* WiT = (const f16*)(F.ws + WS_SMALLW + SW_WIT); const f16* WpT = (const f16*)(F.ws + WS_SMALLW + SW_WPT);
    const f16* Kh = (const f16*)(F.ws + WS_KH); const f16* VT = (const f16*)(F.ws + WS_VT);
    const float* conv_w = F.in[4]; const float* conv_b = F.in[5]; const float* b_a = F.in[7]; const float* b_i = F.in[9]; const float* lam = F.in[10]; const float* pool_scale = F.in[12];
    LAS f16* ucs = (LAS f16*)(F.lds); LAS f16* dts = (LAS f16*)(F.lds + P2_DT_OFF);
    const int w = F.wave;
    const int sub = F.flags ? F.flags : 31;
    for (int ch = F.bx; ch < T / 64; ch += F.G) {
        int tid = F.tid; asm volatile("" : "+v"(tid));
        const int lane = tid & 63, hi = lane >> 5, l31 = lane & 31;
        const int tok0 = ch * 64, t0 = tok0 % SEQ, b = tok0 / SEQ;
        if (sub & 1) {
            const int cp = tid & 255, th = tid >> 8, c0 = 2 * cp;
            const f32x2 cw0 = *(const f32x2*)(conv_w + c0), cw1 = *(const f32x2*)(conv_w + DRNN + c0), cw2 = *(const f32x2*)(conv_w + 2 * DRNN + c0), cw3 = *(const f32x2*)(conv_w + 3 * DRNN + c0), cbv = *(const f32x2*)(conv_b + c0);
            const unsigned* up2 = (const unsigned*)(proj + (size_t)(tok0 + 32 * th) * DIN + c0);
            unsigned raw[35];
#pragma unroll
            for (int i = 0; i < 35; ++i) {
                const int rel = i - 3, lim = -(t0 + 32 * th), rc = rel < lim ? lim : rel;
                const unsigned v = up2[(ptrdiff_t)rc * (DIN / 2)];
                raw[i] = (rel >= lim) ? v : 0u;
            }
            LAS unsigned* dstc = (LAS unsigned*)(ucs + (32 * th) * UCS_PITCH + c0);
            f32x2 u0, u1, u2;
            { const f16x2 h0 = __builtin_bit_cast(f16x2, raw[0]), h1 = __builtin_bit_cast(f16x2, raw[1]), h2 = __builtin_bit_cast(f16x2, raw[2]);
              u0 = (f32x2){(float)h0[0], (float)h0[1]}; u1 = (f32x2){(float)h1[0], (float)h1[1]}; u2 = (f32x2){(float)h2[0], (float)h2[1]}; }
#pragma unroll
            for (int t = 0; t < 32; ++t) {
                const f16x2 h3 = __builtin_bit_cast(f16x2, raw[t + 3]);
                const f32x2 u3 = (f32x2){(float)h3[0], (float)h3[1]};
                const f32x2 v = cbv + cw0 * u0 + cw1 * u1 + cw2 * u2 + cw3 * u3;
                dstc[t * (UCS_PITCH / 2)] = pk_f16(v[0], v[1]);
                u0 = u1; u1 = u2; u2 = u3;
            }
        }
        if (sub & 2) {
            const int g = w & 3, half = w >> 2, cpl = lane & 31, q2 = lane >> 5, ts = 32 * half + 16 * q2, c0 = 64 * g + 2 * cpl;
            const unsigned* pp2 = (const unsigned*)(proj + (size_t)(tok0 + ts) * DIN + 2 * DRNN + c0);
            LAS unsigned* dst = (LAS unsigned*)(dts + ts * DT_PITCH + c0);
            if (g == 0) pool_d2<2>(pp2, t0 + ts, dst); else if (g == 1) pool_d2<4>(pp2, t0 + ts, dst); else if (g == 2) pool_d2<8>(pp2, t0 + ts, dst); else pool_d2<16>(pp2, t0 + ts, dst);
        }
        __syncthreads();
        unsigned sth_[4][8], stp_[4][8];
#pragma unroll
        for (int a = 0; a < 4; ++a)
#pragma unroll
            for (int q = 0; q < 8; ++q) { sth_[a][q] = 0u; stp_[a][q] = 0u; }
        float ownA = 1.f, ownH = 0.f;
        if (sub & 4) {
            const int h = w;
#pragma unroll 1
            for (int cb = 0; cb < 2; ++cb) {
                const int cch = 64 * h + 32 * cb + l31;
                const float ba = b_a[cch], bi = b_i[cch];
                const float sp8 = -8.f * log1pf(expf(-lam[cch]));
                f16x8 wa[4], wi[4], idv[2];
#pragma unroll
                for (int s = 0; s < 4; ++s) {
                    wa[s] = *(const f16x8*)(WaT + ((size_t)(h * 64 + 32 * cb + l31) * 64 + 16 * s + 8 * hi));
                    wi[s] = *(const f16x8*)(WiT + ((size_t)(h * 64 + 32 * cb + l31) * 64 + 16 * s + 8 * hi));
                }
#pragma unroll
                for (int ss = 0; ss < 2; ++ss) {
                    const int jj = l31 - 16 * ss - 8 * hi;
#pragma unroll
                    for (int j = 0; j < 8; ++j) idv[ss][j] = (j == jj) ? (f16)1.f : (f16)0.f;
                }
                float cc = 0.f, Q = 1.f;
#pragma unroll 1
                for (int tb = 0; tb < 2; ++tb) {
                    const LAS f16* arow_ = ucs + (32 * tb + l31) * UCS_PITCH + 64 * h + 8 * hi;
                    f32x16 ar, ai, au;
#pragma unroll
                    for (int r = 0; r < 16; ++r) { ar[r] = 0.f; ai[r] = 0.f; au[r] = 0.f; }
#pragma unroll
                    for (int s = 0; s < 4; ++s) {
                        const f16x8 af = *(const LAS f16x8*)(arow_ + 16 * s);
                        ar = __builtin_amdgcn_mfma_f32_32x32x16_f16(af, wa[s], ar, 0, 0, 0);
                        ai = __builtin_amdgcn_mfma_f32_32x32x16_f16(af, wi[s], ai, 0, 0, 0);
                        if ((s >> 1) == cb) au = __builtin_amdgcn_mfma_f32_32x32x16_f16(af, idv[s & 1], au, 0, 0, 0);
                    }
                    const int tbase = tok0 + 32 * tb + 4 * hi;
                    const f16* gp = proj + (size_t)tbase * DIN + DRNN + cch;
#pragma unroll
                    for (int r = 0; r < 16; ++r) {
                        const int dt = (r & 3) + 8 * (r >> 2);
                        const float rr = sigmoid_fast(ar[r] + ba), ii = sigmoid_fast(ai[r] + bi);
                        const float la = sp8 * rr;
                        const float a = __builtin_amdgcn_exp2f(la * LOG2E);
                        float mult = __builtin_amdgcn_sqrtf(fmaxf(__builtin_fmaf(-a, a, 1.f), 0.f));
                        if (t0 + 32 * tb + 4 * hi + dt == 0) mult = 1.f;
                        ar[r] = a; ai[r] = mult * (ii * au[r]);
                        au[r] = gelu_tanh_fast((float)gp[(size_t)dt * DIN]);
                    }
                    float cin[4], Qin[4];
#pragma unroll
                    for (int rg = 0; rg < 4; ++rg) {
                        float P = ar[4 * rg], hh = ai[4 * rg];
#pragma unroll
                        for (int q = 1; q < 4; ++q) { const float a = ar[4 * rg + q]; hh = a * hh + ai[4 * rg + q]; P = a * P; ar[4 * rg + q] = P; ai[4 * rg + q] = hh; }
                        const float oA = __shfl_xor(P, 32), oH = __shfl_xor(hh, 32);
                        const float A0 = hi ? oA : P, H0 = hi ? oH : hh;
                        const float A1 = hi ? P : oA, H1 = hi ? hh : oH;
                        const float c0 = cc, q0 = Q;
                        cc = A0 * cc + H0; Q = Q * A0;
                        const float c1 = cc, q1 = Q;
                        cc = A1 * cc + H1; Q = Q * A1;
                        cin[rg] = hi ? c1 : c0; Qin[rg] = hi ? q1 : q0;
                    }
#pragma unroll
                    for (int q = 0; q < 8; ++q) { sth_[3][q] = sth_[2][q]; sth_[2][q] = sth_[1][q]; sth_[1][q] = sth_[0][q]; stp_[3][q] = stp_[2][q]; stp_[2][q] = stp_[1][q]; stp_[1][q] = stp_[0][q]; }
#pragma unroll
                    for (int q = 0; q < 8; ++q) {
                        const int r0 = 2 * q, r1 = 2 * q + 1;
                        const float hl0 = ai[r0] + ar[r0] * cin[r0 >> 2], hl1 = ai[r1] + ar[r1] * cin[r1 >> 2];
                        const float pc0 = ar[r0] * Qin[r0 >> 2], pc1 = ar[r1] * Qin[r1 >> 2];
                        sth_[0][q] = pk_f16(hl0 * au[r0], hl1 * au[r1]); stp_[0][q] = pk_f16(pc0 * au[r0], pc1 * au[r1]);
                    }
                }
                if (hi == 0) __hip_atomic_store(AGG + ch * DRNN + cch, ((unsigned long long)__float_as_uint(cc) << 32) | (unsigned long long)__float_as_uint(Q), __ATOMIC_RELAXED, __HIP_MEMORY_SCOPE_AGENT);
                if (cb == hi) { ownA = Q; ownH = cc; }
            }
        }
        const int first = (ch / (SEQ / 64)) * (SEQ / 64), rel = ch - first, grp = rel >> 4, gi = rel & 15, gbase = first + 16 * grp;
        const unsigned long long* agc = AGG + lane + 64 * w;
        unsigned long long* AGG2 = AGG + 256 * DRNN;
        float la = 1.f, lh = 0.f;
        if ((sub & 4) && gi == 15) {
            lookback16(agc + (size_t)gbase * DRNN, 15, la, lh);
            const float ta = ownA * la, thh = ownA * lh + ownH;
            __hip_atomic_store(AGG2 + (size_t)((ch / (SEQ / 64)) * 8 + grp) * DRNN + lane + 64 * w, ((unsigned long long)__float_as_uint(thh) << 32) | __float_as_uint(ta), __ATOMIC_RELAXED, __HIP_MEMORY_SCOPE_AGENT);
        }
        if (sub & 8) {
            const int g = w & 3, th = w >> 2;
            f16x8 Bf[4];
#pragma unroll
            for (int s = 0; s < 4; ++s) Bf[s] = *(const LAS f16x8*)(dts + (32 * th + l31) * DT_PITCH + 64 * g + 16 * s + 8 * hi);
            const size_t tok = (size_t)(tok0 + 32 * th + l31);
#pragma unroll
            for (int cb = 0; cb < 2; ++cb) {
                f32x16 acc;
#pragma unroll
                for (int r = 0; r < 16; ++r) acc[r] = 0.f;
#pragma unroll
                for (int s = 0; s < 4; ++s) { const f16x8 wf = *(const f16x8*)(WpT + ((size_t)(g * 64 + 32 * cb + l31) * 64 + 16 * s + 8 * hi)); acc = __builtin_amdgcn_mfma_f32_32x32x16_f16(wf, Bf[s], acc, 0, 0, 0); }
#pragma unroll
                for (int rg = 0; rg < 4; ++rg) {
                    const int j0 = 32 * cb + 8 * rg + 4 * hi;
                    const f32x4 sc = *(const f32x4*)(pool_scale + 64 * g + j0);
                    u32x2 o; o.x = pk_f16(acc[4 * rg] * sc[0], acc[4 * rg + 1] * sc[1]); o.y = pk_f16(acc[4 * rg + 2] * sc[2], acc[4 * rg + 3] * sc[3]);
                    *(u32x2*)(mixed + tok * D + DRNN + 64 * g + j0) = o;
                }
            }
        }
        if (sub & 4) {
            float ga = 1.f, gh = 0.f;
            if (gi != 15) lookback16(agc + (size_t)gbase * DRNN, gi, la, lh);
            lookback16(AGG2 + (size_t)((ch / (SEQ / 64)) * 8) * DRNN + lane + 64 * w, grp, ga, gh);
            const float carry = la * gh + lh;
            const float carry0 = __shfl(carry, l31), carry1 = __shfl(carry, 32 + l31);
            LAS f16* stg = (LAS f16*)(F.lds + P2_STG_OFF + w * 4096);
#pragma unroll 1
            for (int it = 0; it < 4; ++it) {
                const int cb = it >> 1, tb = it & 1;
                const float cy = cb ? carry1 : carry0;
#pragma unroll
                for (int q = 0; q < 8; ++q) {
                    const f16x2 h2 = __builtin_bit_cast(f16x2, sth_[3][q]), p2 = __builtin_bit_cast(f16x2, stp_[3][q]);
                    const int r0 = 2 * q, r1 = 2 * q + 1;
                    stg[(4 * hi + (r0 & 3) + 8 * (r0 >> 2)) * 32 + l31] = (f16)((float)h2[0] + (float)p2[0] * cy);
                    stg[(4 * hi + (r1 & 3) + 8 * (r1 >> 2)) * 32 + l31] = (f16)((float)h2[1] + (float)p2[1] * cy);
                }
#pragma unroll
                for (int q = 0; q < 8; ++q) { sth_[3][q] = sth_[2][q]; sth_[2][q] = sth_[1][q]; sth_[1][q] = sth_[0][q]; stp_[3][q] = stp_[2][q]; stp_[2][q] = stp_[1][q]; stp_[1][q] = stp_[0][q]; }
                const int tk = lane >> 1, sg2 = lane & 1;
                const u32x4 h0 = *(const LAS u32x4*)(stg + tk * 32 + 8 * sg2), h1 = *(const LAS u32x4*)(stg + tk * 32 + 16 + 8 * sg2);
                const size_t go = (size_t)(tok0 + 32 * tb + tk) * D + 64 * w + 32 * cb + 8 * sg2;
                *(u32x4*)(mixed + go) = h0; *(u32x4*)(mixed + go + 16) = h1;
            }
        }
        if (sub & 16) {
            __syncthreads();
            {
                const char* ksrc = (const char*)(Kh + (size_t)b * NMEM * DX);
#pragma unroll
                for (int j = 0; j < 16; ++j) {
                    const int Pq = tid + 512 * j, key = Pq >> 5, pr = Pq & 31, hd = pr >> 3, chn = pr & 7;
                    const u32x4 v = *(const u32x4*)(ksrc + (size_t)Pq * 16);
                    *(LAS u32x4*)(F.lds + hd * 32768 + key * 128 + ((chn ^ (key & 7)) << 4)) = v;
                }
            }
            const int h = w >> 1, th = w & 1;
            const char* qb = (const char*)(proj + (size_t)(tok0 + 32 * th) * DIN + 2 * DRNN + DPOOL + 64 * h);
            const unsigned qoff = (unsigned)(l31 * DIN + 8 * hi) * 2u;
            f16x8 Qf[4];
#pragma unroll
            for (int s = 0; s < 4; ++s) Qf[s] = *(const f16x8*)(qb + 32 * s + (size_t)qoff);
            const char* vbase = (const char*)(VT + (size_t)b * DX * NMEM + (size_t)(64 * h) * NMEM);
            const unsigned voff = (unsigned)(l31 * NMEM + 8 * hi) * 2u;
            const float scl = 0.125f * LOG2E;
            __syncthreads();
            const LAS unsigned char* kl = F.lds + h * 32768 + l31 * 128;
            const int ksw = l31 & 7;
            float m = -INFINITY;
#pragma unroll 2
            for (int kb = 0; kb < 8; ++kb) {
                f32x16 acc;
#pragma unroll
                for (int r = 0; r < 16; ++r) acc[r] = 0.f;
#pragma unroll
                for (int s = 0; s < 4; ++s) { const f16x8 kfr = *(const LAS f16x8*)(kl + kb * 4096 + (((2 * s + hi) ^ ksw) << 4)); acc = __builtin_amdgcn_mfma_f32_32x32x16_f16(kfr, Qf[s], acc, 0, 0, 0); }
#pragma unroll
                for (int r = 0; r < 16; ++r) m = fmaxf(m, acc[r]);
            }
            m = fmaxf(m, __shfl_xor(m, 32));
            float sum = 0.f;
            f32x16 O[2];
#pragma unroll
            for (int db = 0; db < 2; ++db)
#pragma unroll
                for (int r = 0; r < 16; ++r) O[db][r] = 0.f;
            u32x4 va[2][2], vb2[2][2];
#define LOADV(dst, kb_) do { _Pragma("unroll") for (int s2 = 0; s2 < 2; ++s2) _Pragma("unroll") for (int db = 0; db < 2; ++db) { \
                const char* vp = vbase + (32 * db * NMEM + 32 * (kb_) + 16 * s2) * 2 + (size_t)voff; dst[s2][db] = *(const u32x4*)vp; } } while (0)
            LOADV(va, 0); LOADV(vb2, 1);
#pragma unroll 1
            for (int kb = 0; kb < 8; kb += 2) {
#pragma unroll
                for (int half2 = 0; half2 < 2; ++half2) {
                    const int kbb = kb + half2;
                    f32x16 acc;
#pragma unroll
                    for (int r = 0; r < 16; ++r) acc[r] = 0.f;
#pragma unroll
                    for (int s = 0; s < 4; ++s) { const f16x8 kfr = *(const LAS f16x8*)(kl + kbb * 4096 + (((2 * s + hi) ^ ksw) << 4)); acc = __builtin_amdgcn_mfma_f32_32x32x16_f16(kfr, Qf[s], acc, 0, 0, 0); }
#pragma unroll
                    for (int s2 = 0; s2 < 2; ++s2) {
                        f16x8 pf;
#pragma unroll
                        for (int j = 0; j < 8; ++j) { const float p = __builtin_amdgcn_exp2f((acc[8 * s2 + j] - m) * scl); sum += p; pf[j] = (f16)p; }
#pragma unroll
                        for (int db = 0; db < 2; ++db) {
                            const u32x4 vr = half2 ? vb2[s2][db] : va[s2][db];
                            const auto s0_ = __builtin_amdgcn_permlane32_swap(vr.x, vr.z, false, false), s1_ = __builtin_amdgcn_permlane32_swap(vr.y, vr.w, false, false);
                            u32x4 vq; vq.x = s0_[0]; vq.y = s1_[0]; vq.z = s0_[1]; vq.w = s1_[1];
                            const f16x8 vf = __builtin_bit_cast(f16x8, vq);
                            O[db] = __builtin_amdgcn_mfma_f32_32x32x16_f16(vf, pf, O[db], 0, 0, 0);
                        }
                    }
                    if (half2 == 0) { const int kn = (kb + 2 < 8) ? kb + 2 : 7; LOADV(va, kn); } else { const int kn = (kb + 3 < 8) ? kb + 3 : 7; LOADV(vb2, kn); }
                }
            }
#undef LOADV
            sum += __shfl_xor(sum, 32);
            const float inv = 1.f / sum;
            f16* orow = mixed + (size_t)(tok0 + 32 * th + l31) * D + DRNN + DPOOL + 64 * h + 4 * hi;
#pragma unroll
            for (int db = 0; db < 2; ++db)
#pragma unroll
                for (int rg = 0; rg < 4; ++rg) { u32x2 o; o.x = pk_f16(O[db][4 * rg] * inv, O[db][4 * rg + 1] * inv); o.y = pk_f16(O[db][4 * rg + 2] * inv, O[db][4 * rg + 3] * inv); *(u32x2*)(orow + 32 * db + 8 * rg) = o; }
        }
        asm volatile("s_waitcnt vmcnt(0)" ::: "memory");
        __syncthreads();
    }
}

__device__ __forceinline__ void p5_route(Frame& F) {
    const float* PARTL = (const float*)(F.ws + WS_PARTL); const float* SSQP = (const float*)(F.ws + WS_SSQP); const float* b_r = F.in[18];
    int* list = (int*)(F.ws + WS_LIST); float* glist = (float*)(F.ws + WS_GLIST); float* rlist = (float*)(F.ws + WS_RLIST);
    LAS float* lg = (LAS float*)(F.lds);
    LAS float* rs = (LAS float*)(F.lds + 8448);
    LAS int* sel_e = (LAS int*)(F.lds + 8704);
    LAS int* sel_r = (LAS int*)(F.lds + 9728);
    LAS float* sel_g = (LAS float*)(F.lds + 10752);
    LAS int* lcnt = (LAS int*)(F.lds + 11776);
    LAS int* lbase = (LAS int*)(F.lds + 11904);
    const int w = F.wave, lane = F.lane;
    for (int ch = F.bx; ch < T / 64; ch += F.G) {
        const int tok0 = ch * 64;
        if (F.tid < 32) lcnt[F.tid] = 0;
        {
            const int token = F.tid >> 3, e4 = (F.tid & 7) * 4;
            f32x4 sum = *(const f32x4*)(PARTL + (size_t)(tok0 + token) * 32 + e4); float ss = SSQP[tok0 + token];
#pragma unroll
            for (int pn = 1; pn < 4; ++pn) { sum += *(const f32x4*)(PARTL + ((size_t)pn * T + tok0 + token) * 32 + e4); ss += SSQP[(size_t)pn * T + tok0 + token]; }
            const float rstd = rsqrtf(ss * (1.f / D) + EPS);
            const f32x4 bb = *(const f32x4*)(b_r + e4);
#pragma unroll
            for (int j = 0; j < 4; ++j) lg[token * 33 + e4 + j] = sum[j] * (rstd * (1.f / 1024.f)) + bb[j];
            if ((F.tid & 7) == 0) rs[token] = rstd;
        }
        __syncthreads();
#pragma unroll 1
        for (int p = 0; p < 4; ++p) {
            const int token = 16 * p + 2 * w + (lane >> 5), le = lane & 31;
            float v = lg[token * 33 + le];
            int idx[4]; float val[4];
#pragma unroll
            for (int k = 0; k < 4; ++k) {
                float mx = v;
#pragma unroll
                for (int o = 1; o < 32; o <<= 1) mx = fmaxf(mx, __shfl_xor(mx, o));
                const unsigned long long bal = __ballot(v == mx);
                const unsigned half = (unsigned)(bal >> (lane & 32));
                const int bi = __builtin_ctz(half);
                idx[k] = bi; val[k] = mx;
                if (le == bi) v = -INFINITY;
            }
            if (le == 0) {
                float es[4], sum = 0.f;
#pragma unroll
                for (int k = 0; k < 4; ++k) { es[k] = __expf(val[k] - val[0]); sum += es[k]; }
                const float inv = 1.f / sum;
#pragma unroll
                for (int k = 0; k < 4; ++k) { const int sl = token * 4 + k; sel_e[sl] = idx[k]; sel_g[sl] = es[k] * inv; sel_r[sl] = atomicAdd((int*)&lcnt[idx[k]], 1); }
            }
        }
        __syncthreads();
        if (F.tid < 32) { const int n = lcnt[F.tid]; lbase[F.tid] = n ? (int)atomicAdd(&F.ctl[CW_COUNTS + 64 * F.tid], (unsigned)n) : 0; }
        __syncthreads();
        if (F.tid < 256) { const int e = sel_e[F.tid]; const int li = e * T + lbase[e] + sel_r[F.tid]; list[li] = (tok0 + (F.tid >> 2)) * 4 + (F.tid & 3); glist[li] = sel_g[F.tid]; rlist[li] = rs[F.tid >> 2]; }
        __syncthreads();
    }
}

__device__ __forceinline__ void p8_final(Frame& F) {
    const f16* x1 = (const f16*)(F.ws + WS_X1); const unsigned char* Y = F.ws + WS_Y; const float* g = F.in[23];
    float* out = (float*)F.out;
    const int gw = F.vcu * NWAVES + F.wave, NGW = F.G * NWAVES, lane = F.lane;
    const int per = (T + NGW - 1) / NGW;
    f32x4 gg[4];
#pragma unroll
    for (int j = 0; j < 4; ++j) gg[j] = ((const f32x4*)g)[lane + 64 * j];
    for (int t0 = gw * per; t0 < (gw + 1) * per && t0 < T; t0 += 4) {
        f16x4 xh[4][4]; int yv[4][4][4];
#pragma unroll
        for (int q = 0; q < 4; ++q) {
            const int tok = (t0 + q < T) ? t0 + q : T - 1;
#pragma unroll
            for (int j = 0; j < 4; ++j) {
                xh[q][j] = ((const f16x4*)(x1 + (size_t)tok * D))[lane + 64 * j];
#pragma unroll
                for (int k = 0; k < 4; ++k) yv[q][j][k] = __builtin_nontemporal_load((const int*)(Y + (size_t)(tok * 4 + k) * D + 4 * (lane + 64 * j)));
            }
        }
#pragma unroll
        for (int q = 0; q < 4; ++q) {
            f32x4 v[4]; float s = 0.f;
#pragma unroll
            for (int j = 0; j < 4; ++j) {
                f32x4 a = {(float)xh[q][j][0], (float)xh[q][j][1], (float)xh[q][j][2], (float)xh[q][j][3]};
#pragma unroll
                for (int k = 0; k < 4; ++k) { const f32x2 lo = __builtin_amdgcn_cvt_pk_f32_fp8(yv[q][j][k], false), hi2 = __builtin_amdgcn_cvt_pk_f32_fp8(yv[q][j][k], true);
                    a[0] += lo[0] * (1.f / SC_Y); a[1] += lo[1] * (1.f / SC_Y); a[2] += hi2[0] * (1.f / SC_Y); a[3] += hi2[1] * (1.f / SC_Y); }
                v[j] = a; s += (a[0] * a[0] + a[1] * a[1]) + (a[2] * a[2] + a[3] * a[3]);
            }
            s = wave_sum(s);
            const float r = rsqrtf(s * (1.f / D) + EPS);
            if (t0 + q < T && t0 + q < (gw + 1) * per) {
#pragma unroll
                for (int j = 0; j < 4; ++j) __builtin_nontemporal_store(v[j] * r * gg[j], (f32x4*)(out + (size_t)(t0 + q) * D) + lane + 64 * j);
            }
        }
    }
}

constexpr int NPHASE = 9;
__global__ void __launch_bounds__(NWAVES * 64, 2) mega(Params P) {
    extern __shared__ __attribute__((aligned(16))) unsigned char lds_raw[];
    Frame F;
    F.lds = (LAS unsigned char*)lds_raw;
    F.tid = threadIdx.x; F.lane = F.tid & 63; F.wave = __builtin_amdgcn_readfirstlane(F.tid >> 6);
    F.G = gridDim.x; F.bx = blockIdx.x; F.vcu = (F.G % 8 == 0) ? (F.bx % 8) * (F.G / 8) + F.bx / 8 : F.bx;
    F.ws = P.ws; F.ctl = (unsigned*)(P.ws + WS_CTL); F.in = P.in; F.out = P.out; F.flags = P.flags;
    for (int u = F.tid; u < (LDS_BYTES - LDS_CTL_OFF) / 4; u += NWAVES * 64) ((LAS unsigned*)(F.lds + LDS_CTL_OFF))[u] = 0u;
    __syncthreads();
    const int lo = P.ph_lo, hi = P.ph_hi;
    XcdBarrier bar; bar.bar = F.ctl + CW_BAR; bar.x = 0; bar.st = nullptr;
    if (hi - lo > 1) bar = xcd_barrier_post(F.ctl + CW_BAR, (volatile LAS unsigned*)(F.lds + LDS_CTL_OFF + 32));
#define IN(k) (lo <= (k) && (k) < hi)
#define SEAM(k) do { if (IN(k) && IN((k) + 1)) xcd_barrier(bar); } while (0)
    if (IN(0)) { p0_prologue(F); p0_small(F); SEAM(0); }
    if (IN(1)) {
        SchedP1 S{(const char*)(F.ws + WS_H0), (const char*)(F.ws + WS_WINT), (const char*)(F.ws + WS_MEMN), (const char*)(F.ws + WS_WKVT), F.G, F.bx};
        EpiP1 E{(f16*)(F.ws + WS_PROJ), (f16*)(F.ws + WS_KH), (f16*)(F.ws + WS_VT), (const float*)(F.ws + WS_RSTD0)};
        pg::gemm_phase(F.lds, S, E);
        p1_deferred_items(F);
        SEAM(1);
    }
    if (IN(2)) { p2_mixer(F); if (!IN(3)) {} }
    if (IN(3)) { SEAM(3); }
    if (IN(4)) {
        EpiP3 E{(const f16*)(F.ws + WS_H0), (f16*)(F.ws + WS_X1), F.ws + WS_X1N, F.in[16], (const f16*)(F.ws + WS_SMALLW + SW_WRP), (float*)(F.ws + WS_PARTL), (float*)(F.ws + WS_SSQP), F.lds};
        for (int L = F.bx; L < 64 * 4; L += F.G) { SchedP3 S{(const char*)(F.ws + WS_MIXED), (const char*)(F.ws + WS_WOUTT), L}; pg::gemm_phase(F.lds, S, E); }
        SEAM(4);
    }
    if (IN(5)) { p5_route(F); SEAM(5); }
    if (IN(6)) {
        moe_table(F);
        SchedMoe<8, true> S{(const char*)(F.ws + WS_X1N), (const char*)(F.ws + WS_WGUT), (size_t)2 * DFF * pg::ROWB8, (const int*)(F.ws + WS_LIST), (const LAS int*)(F.lds + LDS_CTL_OFF + 256), F.G, F.bx};
        EpiGU E{F.in[20], (const float*)(F.ws + WS_RLIST), (unsigned char*)(F.ws + WS_HBUF), F.flags & 1};
        pg::gemm_phase(F.lds, S, E);
        SEAM(6);
    }
    if (IN(7)) {
        moe_table(F);
        SchedMoe<4, false> S{(const char*)(F.ws + WS_HBUF), (const char*)(F.ws + WS_WDT), (size_t)D * pg::ROWB8, (const int*)(F.ws + WS_LIST), (const LAS int*)(F.lds + LDS_CTL_OFF + 256), F.G, F.bx};
        EpiDown E{F.in[22], (const int*)(F.ws + WS_LIST), (const float*)(F.ws + WS_GLIST), (unsigned char*)(F.ws + WS_Y), F.flags & 1};
        pg::gemm_phase(F.lds, S, E);
        SEAM(7);
    }
    if (IN(8)) { p8_final(F); }
#undef IN
#undef SEAM
}
}

extern "C" void kernel_launch(void* const* d_in, const int* in_sizes, int n_in, void* d_out, int out_size, void* d_ws, size_t ws_size, hipStream_t stream) {
    static int grid = 0;
    if (grid == 0) {
        if (n_in != 24 || ws_size < WS_END) { fprintf(stderr, "kernel_launch: unexpected n_in %d / ws %zu\n", n_in, ws_size); grid = -1; return; }
        int dev = 0, cus = 0;
        (void)hipGetDevice(&dev); (void)hipDeviceGetAttribute(&cus, hipDeviceAttributeMultiprocessorCount, dev);
        if (hipFuncSetAttribute((const void*)mega, hipFuncAttributeMaxDynamicSharedMemorySize, LDS_BYTES) != hipSuccess) { fprintf(stderr, "kernel_launch: hipFuncSetAttribute failed\n"); grid = -1; return; }
        int per_cu = 0;
        if (hipOccupancyMaxActiveBlocksPerMultiprocessor(&per_cu, (const void*)mega, NWAVES * 64, LDS_BYTES) != hipSuccess || per_cu < 1) fprintf(stderr, "kernel_launch: occupancy query says %d\n", per_cu);
        (void)hipGetLastError();
        grid = cus;
        if (grid % 8 != 0) fprintf(stderr, "kernel_launch: grid %d not a multiple of 8\n", grid);
    }
    if (grid < 0) return;
    unsigned char* ws = (unsigned char*)d_ws;
    (void)hipMemsetAsync(ws + WS_CTL, 0, 32768, stream);
    Params p{};
    for (int i = 0; i < 24; ++i) p.in[i] = (const float*)d_in[i];
    p.out = (float*)d_out; p.ws = ws;
    p.ph_lo = 0; p.ph_hi = NPHASE;
    hipLaunchKernelGGL(mega, dim3(grid), dim3(NWAVES * 64), LDS_BYTES, stream, p);
}
```
